# Optimizing an MI355X kernel written in HIP

```python
import jax, jax.numpy as jnp
from jax import lax
import numpy as np

D_MODEL = 1024
BATCH = 4
SEQ = 4096
DEPTH = 1

RET_HEADS = 8
RET_DK = 64
RET_DV = 128
DN_HEADS = 8
DN_DK = 128
DN_DV = 128
CHUNK = 128
SHORT_CONV = 4
FFN_CONV = 3
D_FF = 2816
ROPE_BASE = 10000.0
EPS = 1e-6
GN_EPS = 1e-5

RET_QK = RET_HEADS * RET_DK
RET_V = RET_HEADS * RET_DV
DN_QK = DN_HEADS * DN_DK
DN_V = DN_HEADS * DN_DV
SPLITS = (RET_QK, RET_QK, RET_V, RET_V, DN_QK, DN_QK, DN_V, DN_V, DN_HEADS, DN_HEADS, D_MODEL, D_MODEL)
D_IN = sum(SPLITS)
DN_CONV_CH = 2 * DN_QK + DN_V

kernel_name = "retention_gated_deltanet_convffn_hybrid"


def rmsnorm(x, g):
    xf = x.astype(jnp.float32)
    r = lax.rsqrt(jnp.mean(xf * xf, axis=-1, keepdims=True) + EPS)
    return (xf * r) * g


def l2norm(x):
    xf = x.astype(jnp.float32)
    return xf * lax.rsqrt(jnp.sum(xf * xf, axis=-1, keepdims=True) + EPS)


def rotary(x):
    T, d = x.shape[1], x.shape[-1]
    inv = ROPE_BASE ** (-jnp.arange(0, d, 2, dtype=jnp.float32) / d)
    ang = jnp.arange(T, dtype=jnp.float32)[:, None] * inv[None, :]
    cos = jnp.cos(ang)[None, :, None, :]
    sin = jnp.sin(ang)[None, :, None, :]
    x1, x2 = x[..., : d // 2], x[..., d // 2:]
    return jnp.concatenate([x1 * cos - x2 * sin, x1 * sin + x2 * cos], axis=-1)


def causal_dwconv(x, w):
    K, T = w.shape[0], x.shape[1]
    xp = jnp.pad(x, ((0, 0), (K - 1, 0), (0, 0)))
    y = xp[:, K - 1:K - 1 + T] * w[K - 1]
    for k in range(K - 1):
        y = y + xp[:, k:k + T] * w[k]
    return y


def retention_chunkwise(q, k, v):
    B, T, H, dk = q.shape
    dv = v.shape[-1]
    N = T // CHUNK
    f32 = jnp.float32
    gamma = 1.0 - 2.0 ** (-5.0 - jnp.arange(H, dtype=f32))
    log_g = jnp.log(gamma)
    idx = jnp.arange(CHUNK, dtype=f32)
    qc = q.astype(f32).reshape(B, N, CHUNK, H, dk)
    kc = k.astype(f32).reshape(B, N, CHUNK, H, dk)
    vc = v.astype(f32).reshape(B, N, CHUNK, H, dv)
    diff = idx[:, None] - idx[None, :]
    causal = diff >= 0
    dmat = jnp.where(causal[None], jnp.exp(log_g[:, None, None] * jnp.where(causal, diff, 0.0)[None]), 0.0)
    scores = jnp.einsum('bnihd,bnjhd->bnhij', qc, kc) * dmat
    inner = jnp.einsum('bnhij,bnjhv->bnihv', scores, vc)
    zeta = jnp.exp(log_g[:, None] * (CHUNK - 1.0 - idx)[None, :])
    kv = jnp.einsum('bnjhd,hj,bnjhv->bnhdv', kc, zeta, vc)
    chunk_decay = jnp.exp(log_g * CHUNK)[:, None, None]

    def step(S, kv_n):
        return S * chunk_decay + kv_n, S

    _, s_prev = lax.scan(step, jnp.zeros((B, H, dk, dv), f32), jnp.moveaxis(kv, 1, 0))
    xi = jnp.exp(log_g[:, None] * (idx + 1.0)[None, :])
    cross = jnp.einsum('bnihd,nbhdv,hi->bnihv', qc, s_prev, xi)
    return (inner + cross).reshape(B, T, H, dv)


def gated_delta_chunkwise(q, k, v, g, beta):
    B, T, H, dk = q.shape
    dv = v.shape[-1]
    N = T // CHUNK
    f32 = jnp.float32

    def to_chunks(t):
        return jnp.moveaxis(t.astype(f32).reshape((B, N, CHUNK, H) + t.shape[3:]), 3, 1)

    qc = to_chunks(q) * (dk ** -0.5)
    kc = to_chunks(k)
    vc = to_chunks(v)
    gc = to_chunks(g)
    bc = to_chunks(beta)
    G = jnp.cumsum(gc, axis=-1)
    idx = jnp.arange(CHUNK)
    causal = idx[:, None] >= idx[None, :]
    strict = idx[:, None] > idx[None, :]
    diff = G[..., :, None] - G[..., None, :]
    L = jnp.where(causal, jnp.exp(jnp.where(causal, diff, 0.0)), 0.0)
    k_beta = kc * bc[..., None]
    A = jnp.where(strict, jnp.einsum('bhnid,bhnjd->bhnij', k_beta, kc) * L, 0.0)
    eye = jnp.eye(CHUNK, dtype=f32)
    rhs = jnp.concatenate([vc * bc[..., None], k_beta * jnp.exp(G)[..., None]], axis=-1)
    sol = lax.linalg.triangular_solve(eye + A, rhs, left_side=True, lower=True, unit_diagonal=True)
    u, w = sol[..., :dv], sol[..., dv:]
    attn = jnp.where(causal, jnp.einsum('bhnid,bhnjd->bhnij', qc, kc) * L, 0.0)
    q_dec = qc * jnp.exp(G)[..., None]
    k_dec = kc * jnp.exp(G[..., -1:] - G)[..., None]
    chunk_dec = jnp.exp(G[..., -1])

    def step(S, inp):
        u_n, w_n, q_n, k_n, a_n, d_n = inp
        v_new = u_n - jnp.einsum('bhcd,bhdv->bhcv', w_n, S)
        o = jnp.einsum('bhcd,bhdv->bhcv', q_n, S) + jnp.einsum('bhij,bhjv->bhiv', a_n, v_new)
        S = S * d_n[..., None, None] + jnp.einsum('bhcd,bhcv->bhdv', k_n, v_new)
        return S, o

    xs = tuple(jnp.moveaxis(t, 2, 0) for t in (u, w, q_dec, k_dec, attn, chunk_dec))
    _, o = lax.scan(step, jnp.zeros((B, H, dk, dv), f32), xs)
    return o.transpose(1, 0, 3, 2, 4).reshape(B, T, H, dv)


def setup_inputs(seed: int = 0) -> dict:
    key = jax.random.key(seed)
    ks = jax.random.split(key, 20)
    f32 = jnp.float32
    nrm = lambda k, shape, s: jax.random.normal(k, shape, f32) * s
    dt = jnp.exp(jax.random.uniform(ks[6], (DEPTH, DN_HEADS), f32, np.log(1e-3), np.log(1e-1)))
    return {
        "x": jax.random.normal(ks[0], (BATCH, SEQ, D_MODEL), f32),
        "g_mix": 1.0 + nrm(ks[1], (DEPTH, D_MODEL), 0.05),
        "w_in": nrm(ks[2], (DEPTH, D_MODEL, D_IN), D_MODEL ** -0.5),
        "ret_norm_g": 1.0 + nrm(ks[3], (DEPTH, RET_V), 0.05),
        "dn_conv_w": nrm(ks[4], (DEPTH, SHORT_CONV, DN_CONV_CH), SHORT_CONV ** -0.5),
        "dn_a_log": jnp.log(jax.random.uniform(ks[5], (DEPTH, DN_HEADS), f32, 1.0, 16.0)),
        "dn_dt_bias": dt + jnp.log(-jnp.expm1(-dt)),
        "dn_norm_g": 1.0 + nrm(ks[7], (DEPTH, DN_DV), 0.05),
        "w_ret_br": nrm(ks[8], (DEPTH, RET_V, D_MODEL), RET_V ** -0.5),
        "w_dn_br": nrm(ks[9], (DEPTH, DN_V, D_MODEL), DN_V ** -0.5),
        "w_o": nrm(ks[10], (DEPTH, D_MODEL, D_MODEL), D_MODEL ** -0.5),
        "g_ffn": 1.0 + nrm(ks[11], (DEPTH, D_MODEL), 0.05),
        "w_up": nrm(ks[12], (DEPTH, D_MODEL, 2 * D_FF), D_MODEL ** -0.5),
        "ffn_conv_w": nrm(ks[13], (DEPTH, FFN_CONV, 2 * D_FF), FFN_CONV ** -0.5),
        "ffn_conv_b": nrm(ks[14], (DEPTH, 2 * D_FF), 0.01),
        "w_down": nrm(ks[15], (DEPTH, D_FF, D_MODEL), D_FF ** -0.5),
        "g_final": 1.0 + nrm(ks[16], (D_MODEL,), 0.05),
    }


def reference(x, g_mix, w_in, ret_norm_g, dn_conv_w, dn_a_log, dn_dt_bias, dn_norm_g,
              w_ret_br, w_dn_br, w_o, g_ffn, w_up, ffn_conv_w, ffn_conv_b, w_down, g_final):
    B, T, _ = x.shape
    h = x.astype(jnp.float32)
    split_at = np.cumsum(SPLITS)[:-1].tolist()
    for l in range(DEPTH):
        u = rmsnorm(h, g_mix[l])
        proj = u @ w_in[l]
        (rq, rk, rv, rgate, dq, dk_, dv_, dz, db, da, gate_r, gate_d) = jnp.split(proj, split_at, axis=-1)

        rq = rotary(rq.reshape(B, T, RET_HEADS, RET_DK))
        rk = rotary(rk.reshape(B, T, RET_HEADS, RET_DK)) * (RET_DK ** -0.5)
        ro = retention_chunkwise(rq, rk, rv.reshape(B, T, RET_HEADS, RET_DV))
        mu = jnp.mean(ro, axis=-1, keepdims=True)
        var = jnp.mean(jnp.square(ro - mu), axis=-1, keepdims=True)
        ro = ((ro - mu) * lax.rsqrt(var + GN_EPS)).reshape(B, T, RET_V) * ret_norm_g[l]
        y_ret = (jax.nn.silu(rgate) * ro) @ w_ret_br[l]

        qkv = jax.nn.silu(causal_dwconv(jnp.concatenate([dq, dk_, dv_], axis=-1), dn_conv_w[l]))
        cq, ck, cv = jnp.split(qkv, [DN_QK, 2 * DN_QK], axis=-1)
        cq = l2norm(cq.reshape(B, T, DN_HEADS, DN_DK))
        ck = l2norm(ck.reshape(B, T, DN_HEADS, DN_DK))
        cv = cv.reshape(B, T, DN_HEADS, DN_DV)
        g = -jnp.exp(dn_a_log[l]) * jax.nn.softplus(da.astype(jnp.float32) + dn_dt_bias[l])
        beta = jax.nn.sigmoid(db.astype(jnp.float32))
        do = gated_delta_chunkwise(cq, ck, cv, g, beta)
        do = do * lax.rsqrt(jnp.mean(do * do, axis=-1, keepdims=True) + EPS) * dn_norm_g[l]
        do = do.reshape(B, T, DN_V) * jax.nn.silu(dz)
        y_dn = do @ w_dn_br[l]

        merged = jax.nn.sigmoid(gate_r) * y_ret + jax.nn.sigmoid(gate_d) * y_dn
        h = h + merged @ w_o[l]

        u2 = rmsnorm(h, g_ffn[l])
        up = causal_dwconv(u2 @ w_up[l], ffn_conv_w[l]) + ffn_conv_b[l]
        a, b = jnp.split(up, 2, axis=-1)
        h = h + (jax.nn.silu(a) * b) @ w_down[l]
    return rmsnorm(h, g_final).astype(x.dtype)
```

```cpp
#include <hip/hip_runtime.h>
#include <hip/hip_cooperative_groups.h>
#include <cstdio>
#include <cstdint>
namespace cg = cooperative_groups;
namespace pg8 {
#define PG8_LAS __attribute__((address_space(3)))
typedef unsigned short bf16_t;
typedef short bf16x8 __attribute__((ext_vector_type(8)));
typedef float f32x4 __attribute__((ext_vector_type(4)));
typedef unsigned u32x4 __attribute__((ext_vector_type(4)));
constexpr int BM = 256, BK = 64, HALF = 128, HTB = HALF * BK * 2  , STAGE_BYTES = 8 * HTB, NXCD = 8, WGM = 8;

__host__ __device__ __forceinline__ int lds_byte(int r, int c) { const int st = (r >> 4) * 2 + (c >> 5), rr = r & 15, cc = c & 31, ob = rr * 64 + cc * 2; return st * 1024 + (ob ^ (((ob >> 9) & 1) << 5)); }
__host__ __device__ __forceinline__ void stage_rc(int b, int& R, int& C) { const int st = b / 1024, sb = b % 1024, swz = sb ^ (((sb >> 9) & 1) << 5); R = (st >> 1) * 16 + swz / 64; C = (st & 1) * 32 + (swz % 64) / 2; }
__host__ __device__ __forceinline__ int perm32(int rho) { const int n = rho >> 4, i = rho & 15; return 8 * (i >> 2) + 4 * n + (i & 3); }

struct Unit { int pm, pn; };
struct Gemm { const bf16_t* A; const bf16_t* Bt; int M, N, K, lda, ldb; };

struct StaticOrder {
    int nM, nN, nwg, G, c;
    __host__ __device__ void init(int M, int N, int G_, int c_) { nM = M / BM; nN = N / BM; nwg = nM * nN; G = G_; c = c_; }
    __host__ __device__ bool next(int i, Unit& u) const {
        const long L = (long)i * G + c; if (L >= nwg) return false;
        int wgid = (int)L; { const int q = nwg / NXCD, r = nwg % NXCD, xcd = wgid % NXCD, off = wgid / NXCD; wgid = (xcd < r ? xcd * (q + 1) : r * (q + 1) + (xcd - r) * q) + off; }
        const int nig = WGM * nN, gid = wgid / nig, fm = gid * WGM, gsz = (nM - fm) < WGM ? (nM - fm) : WGM;
        u.pm = fm + ((wgid % nig) % gsz); u.pn = (wgid % nig) / gsz; return true;
    }
    __device__ __forceinline__ void a_ready(const Unit&) const {}
    __device__ __forceinline__ void done(const Unit&) const {}
};

__device__ __forceinline__ unsigned cvt_pk_bf16(float lo, float hi) { unsigned r; asm volatile("v_cvt_pk_bf16_f32 %0, %1, %2" : "=v"(r) : "v"(lo), "v"(hi)); return r; }
template <class Epi, class Sched, bool ALIGN_EPI = false, bool SP2 = false>
__device__ __forceinline__ void gemm_phase(PG8_LAS unsigned char* lds, const Gemm g, const Sched& S, const Epi& E) {
    const int tid = threadIdx.x, wid = __builtin_amdgcn_readfirstlane(tid >> 6), lane = tid & 63, wr = wid >> 2, wc = wid & 3, fr = lane & 15, fq = lane >> 4;
    const int K = g.K, nt = K / BK;
    unsigned voffA[2], voffB[2];
#pragma unroll
    for (int i = 0; i < 2; ++i) { int R, C; stage_rc(tid * 16 + i * 8192, R, C); const int Rb = Epi::PERM ? ((R & ~31) + perm32(R & 31)) : R;
        voffA[i] = (unsigned)(R * g.lda + C) * 2u; voffB[i] = (unsigned)(Rb * g.ldb + C) * 2u; }
    const size_t kstep = (size_t)(BK * 2);
    const size_t hstepA = (size_t)HALF * g.lda * 2, hstepB = (size_t)HALF * g.ldb * 2;
    const size_t tstepA = 2 * hstepA, tstepB = 2 * hstepB;
    const unsigned ldsw = (unsigned)wid * 1024u;
    const int aoff = lds_byte(wr * 64 + fr, fq * 8), boff = lds_byte(wc * 32 + fr, fq * 8);
#define PG8_SA(b, h) (((b) * 2 + (h)) * HTB)
#define PG8_SB(b, h) ((4 + (b) * 2 + (h)) * HTB)
#define PG8_STAGE(bufoff, gbase, voff) do { _Pragma("unroll") for (int _i = 0; _i < 2; ++_i) \
        __builtin_amdgcn_global_load_lds((const unsigned*)((const char*)(gbase) + (voff)[_i]), (PG8_LAS unsigned*)(lds + (bufoff) + ldsw + _i * 8192), 16, 0, 0); } while (0)
#define PG8_LDA(dst, b, h) do { _Pragma("unroll") for (int m = 0; m < 4; ++m) _Pragma("unroll") for (int k = 0; k < 2; ++k) dst[m][k] = *(const PG8_LAS bf16x8*)(lds + PG8_SA(b, h) + aoff + m * 2048 + k * 1024); } while (0)
#define PG8_LDB(dst, b, h) do { _Pragma("unroll") for (int n = 0; n < 2; ++n) _Pragma("unroll") for (int k = 0; k < 2; ++k) dst[n][k] = *(const PG8_LAS bf16x8*)(lds + PG8_SB(b, h) + boff + n * 2048 + k * 1024); } while (0)
#define PG8_MMA(ai, bj, At, Bt) do { __builtin_amdgcn_s_setprio(1); _Pragma("unroll") for (int m = 0; m < 4; ++m) _Pragma("unroll") for (int n = 0; n < 2; ++n) _Pragma("unroll") for (int k = 0; k < 2; ++k) \
        acc[ai][bj][m][n] = __builtin_amdgcn_mfma_f32_16x16x32_bf16(Bt[n][k], At[m][k], acc[ai][bj][m][n], 0, 0, 0); __builtin_amdgcn_s_setprio(0); } while (0)
#define PG8_WAIT_V(n) asm volatile("s_waitcnt vmcnt(" #n ")" ::: "memory")
#define PG8_WAIT_L(n) asm volatile("s_waitcnt lgkmcnt(" #n ")" ::: "memory")
#define PG8_BAR __builtin_amdgcn_s_barrier()
#define PG8_SCHED __builtin_amdgcn_sched_barrier(0)
    Unit cur, nxt; int ui = 0;
    if (!S.next(0, cur)) return;
    f32x4 acc[2][2][4][2];
#pragma unroll
    for (int a = 0; a < 2; ++a)
#pragma unroll
        for (int b = 0; b < 2; ++b)
#pragma unroll
            for (int m = 0; m < 4; ++m)
#pragma unroll
                for (int n = 0; n < 2; ++n) acc[a][b][m][n] = (f32x4){0.f, 0.f, 0.f, 0.f};
    bf16x8 At[4][2], B0[2][2], B1[2][2];
    const char* cA = (const char*)g.A + (size_t)cur.pm * tstepA; const char* cB = (const char*)g.Bt + (size_t)cur.pn * tstepB;
    S.a_ready(cur);
    if constexpr (SP2) {
        PG8_STAGE(PG8_SB(0, 0), cB, voffB); PG8_STAGE(PG8_SB(0, 1), cB + hstepB, voffB); PG8_STAGE(PG8_SA(0, 0), cA, voffA); PG8_STAGE(PG8_SA(0, 1), cA + hstepA, voffA);
        if (wr == 1) PG8_BAR;
        PG8_WAIT_V(2); PG8_BAR;
        PG8_STAGE(PG8_SB(1, 0), cB + kstep, voffB); PG8_STAGE(PG8_SA(1, 0), cA + kstep, voffA); PG8_STAGE(PG8_SB(1, 1), cB + hstepB + kstep, voffB);
        PG8_WAIT_V(6); PG8_BAR;
    } else {
        PG8_STAGE(PG8_SB(0, 0), cB, voffB); PG8_STAGE(PG8_SA(0, 0), cA, voffA); PG8_STAGE(PG8_SB(0, 1), cB + hstepB, voffB); PG8_STAGE(PG8_SA(0, 1), cA + hstepA, voffA);
        if (wr == 1) PG8_BAR;
        PG8_WAIT_V(4); PG8_BAR;
        PG8_STAGE(PG8_SB(1, 0), cB + kstep, voffB); PG8_STAGE(PG8_SA(1, 0), cA + kstep, voffA); PG8_STAGE(PG8_SB(1, 1), cB + hstepB + kstep, voffB);
        PG8_WAIT_V(6); PG8_BAR;
    }
    for (;;) {
        const bool has_next = S.next(ui + 1, nxt);
        const char* nA = has_next ? (const char*)g.A + (size_t)nxt.pm * tstepA : cA; const char* nB = has_next ? (const char*)g.Bt + (size_t)nxt.pn * tstepB : cB;
        for (int t = 0; t < nt; t += 2) {
            const bool last = (t == nt - 2);
            const char* a1 = cA + (size_t)(t + 1) * kstep;
            const char* a2 = last ? nA : cA + (size_t)(t + 2) * kstep; const char* b2 = last ? nB : cB + (size_t)(t + 2) * kstep;
            const char* a3 = a2 + kstep; const char* b3 = b2 + kstep;
            if (last && has_next) S.a_ready(nxt);
            if constexpr (SP2) {
            PG8_LDB(B0, 0, 0); PG8_LDB(B1, 0, 1); PG8_SCHED; PG8_LDA(At, 0, 0); PG8_STAGE(PG8_SA(1, 1), a1 + hstepA, voffA);
            PG8_WAIT_V(8); PG8_WAIT_L(0); PG8_BAR; PG8_MMA(0, 0, At, B0); PG8_MMA(0, 1, At, B1); PG8_BAR; PG8_SCHED;
            PG8_LDA(At, 0, 1); PG8_STAGE(PG8_SB(0, 0), b2, voffB); PG8_STAGE(PG8_SB(0, 1), b2 + hstepB, voffB); PG8_STAGE(PG8_SA(0, 0), a2, voffA);
            PG8_WAIT_V(8); PG8_WAIT_L(0); PG8_BAR; PG8_MMA(1, 0, At, B0); PG8_MMA(1, 1, At, B1); PG8_BAR; PG8_SCHED;
            PG8_LDB(B0, 1, 0); PG8_LDB(B1, 1, 1); PG8_SCHED; PG8_LDA(At, 1, 0); PG8_STAGE(PG8_SA(0, 1), a2 + hstepA, voffA);
            PG8_WAIT_V(8); PG8_WAIT_L(0); PG8_BAR; PG8_MMA(0, 0, At, B0); PG8_MMA(0, 1, At, B1); PG8_BAR; PG8_SCHED;
            PG8_LDA(At, 1, 1); PG8_STAGE(PG8_SB(1, 0), b3, voffB); PG8_STAGE(PG8_SB(1, 1), b3 + hstepB, voffB); PG8_STAGE(PG8_SA(1, 0), a3, voffA);
            PG8_WAIT_V(8); PG8_WAIT_L(0); PG8_BAR; PG8_MMA(1, 0, At, B0); PG8_MMA(1, 1, At, B1); PG8_BAR; PG8_SCHED;
            } else {
            PG8_LDB(B0, 0, 0); PG8_SCHED; PG8_LDA(At, 0, 0); PG8_STAGE(PG8_SA(1, 1), a1 + hstepA, voffA);
            PG8_WAIT_L(8); PG8_BAR; PG8_WAIT_L(0); PG8_MMA(0, 0, At, B0); PG8_BAR; PG8_SCHED;
            PG8_LDB(B1, 0, 1); PG8_STAGE(PG8_SB(0, 0), b2, voffB);
            PG8_BAR; PG8_WAIT_L(0); PG8_MMA(0, 1, At, B1); PG8_BAR;
            PG8_LDA(At, 0, 1); PG8_STAGE(PG8_SA(0, 0), a2, voffA);
            PG8_BAR; PG8_WAIT_L(0); PG8_MMA(1, 0, At, B0); PG8_BAR; PG8_SCHED;
            PG8_STAGE(PG8_SB(0, 1), b2 + hstepB, voffB);
            PG8_WAIT_V(6); PG8_BAR; PG8_MMA(1, 1, At, B1); PG8_BAR;
            PG8_LDB(B0, 1, 0); PG8_SCHED; PG8_LDA(At, 1, 0); PG8_STAGE(PG8_SA(0, 1), a2 + hstepA, voffA);
            PG8_WAIT_L(8); PG8_BAR; PG8_WAIT_L(0); PG8_MMA(0, 0, At, B0); PG8_BAR; PG8_SCHED;
            PG8_LDB(B1, 1, 1); PG8_STAGE(PG8_SB(1, 0), b3, voffB);
            PG8_BAR; PG8_WAIT_L(0); PG8_MMA(0, 1, At, B1); PG8_BAR;
            PG8_LDA(At, 1, 1); PG8_STAGE(PG8_SA(1, 0), a3, voffA);
            PG8_BAR; PG8_WAIT_L(0); PG8_MMA(1, 0, At, B0); PG8_BAR; PG8_SCHED;
            PG8_STAGE(PG8_SB(1, 1), b3 + hstepB, voffB);
            PG8_WAIT_V(6); PG8_BAR; PG8_MMA(1, 1, At, B1); PG8_BAR;
            }
        }
        if constexpr (ALIGN_EPI) { if (wr == 0) PG8_BAR; }
        if constexpr (!Epi::AFTER_DRAIN) { E(acc, cur, wr, wc, fr, fq); S.done(cur); }
        if (!has_next) break;
#pragma unroll
        for (int a = 0; a < 2; ++a)
#pragma unroll
            for (int b = 0; b < 2; ++b)
#pragma unroll
                for (int m = 0; m < 4; ++m)
#pragma unroll
                    for (int n = 0; n < 2; ++n) acc[a][b][m][n] = (f32x4){0.f, 0.f, 0.f, 0.f};
        cur = nxt; cA = nA; cB = nB; ++ui;
        if constexpr (ALIGN_EPI) { if (wr == 1) PG8_BAR; }
    }
    PG8_WAIT_V(0);
    if constexpr (!ALIGN_EPI) { if (wr == 0) PG8_BAR; }
    PG8_BAR;
    if constexpr (Epi::AFTER_DRAIN) { E.fused(acc, cur, wr, wc, fr, fq, lds, wid, lane); S.done(cur); }
#undef PG8_SA
#undef PG8_SB
#undef PG8_STAGE
#undef PG8_LDA
#undef PG8_LDB
#undef PG8_MMA
#undef PG8_WAIT_V
#undef PG8_WAIT_L
#undef PG8_BAR
#undef PG8_SCHED
}
}
#define DBG_SOLVE 0
#define NPHASE_STEPS 11
#define PROGRAM_STEPS STEP(0, 0) STEP(1, 1) STEP(2, 2) STEP(3, 3) STEP(4, 4) STEP(5, 5) STEP(6, 6) STEP(7, 7) STEP(8, 8) STEP(9, 10) STEP(10, 11)
typedef unsigned short bf16;
typedef short bf16x8 __attribute__((ext_vector_type(8)));
typedef short bf16x4 __attribute__((ext_vector_type(4)));
typedef float f32x4 __attribute__((ext_vector_type(4)));
typedef float f32x2 __attribute__((ext_vector_type(2)));
typedef unsigned u32x4 __attribute__((ext_vector_type(4)));
typedef unsigned u32x2 __attribute__((ext_vector_type(2)));

constexpr int NB = 4, T = 4096, D = 1024, M = NB * T, H = 8, CH = 128, NCH = T / CH;
constexpr int DFF = 2816, NUP = 2 * DFF;
constexpr int N1 = 5120, N5 = 4096, NIN = 9216, DIN = 9232;
constexpr float EPS = 1e-6f, GN_EPS = 1e-5f;
constexpr size_t MiB = 1u << 20;
constexpr size_t WS_CTL = 0, CTL_BYTES = 16384;
constexpr size_t WS_R1 = MiB / 4, WS_GB = MiB / 2, WS_SS1 = 3 * MiB / 2, WS_SS2 = 5 * MiB / 2, WS_ROPE = 7 * MiB / 2, WS_GC = 9 * MiB / 2, WS_HALO = 5 * MiB;
constexpr size_t WS_WIN = 8 * MiB;
constexpr size_t WS_KV = 16 * MiB, WS_UX = 32 * MiB, WS_H1B = 32 * MiB;
constexpr size_t WS_RQ = 64 * MiB, WS_RK = 80 * MiB, WS_RV = 96 * MiB, WS_DQ = 128 * MiB, WS_DK = 160 * MiB, WS_DV = 192 * MiB;
constexpr size_t WS_SN = 224 * MiB;
constexpr size_t WS_WRET = 224 * MiB, WS_WDN = 226 * MiB, WS_WO = 228 * MiB, WS_WUP = 230 * MiB, WS_WDOWN = 241 * MiB;
constexpr size_t WS_ACT = 64 * MiB, WS_HBUF = 152 * MiB, WS_END = 256 * MiB;
constexpr size_t OUT_W = 0, OUT_KDT = 32 * MiB;
constexpr int LDS_BYTES = 147456;
#ifndef NPHASE_STEPS
#define NPHASE_STEPS 11
#endif
constexpr int NPHASE = NPHASE_STEPS;

#ifndef N_LAUNCH_MODE
#define N_LAUNCH_MODE 1
#endif

typedef __bf16 bf16x2n __attribute__((ext_vector_type(2)));
__device__ __forceinline__ unsigned pk2(float lo, float hi) { const f32x2 f = {lo, hi}; return __builtin_bit_cast(unsigned, __builtin_convertvector(f, bf16x2n)); }
__device__ __forceinline__ float bflo(unsigned u) { return __uint_as_float(u << 16); }
__device__ __forceinline__ float bfhi(unsigned u) { return __uint_as_float(u & 0xffff0000u); }
__device__ __forceinline__ float bf2f(bf16 h) { return __uint_as_float(((unsigned)h) << 16); }
__device__ __forceinline__ bf16 f2bf(float f) { return (bf16)(pk2(f, 0.f) & 0xffffu); }
__device__ __forceinline__ float silu_f(float x) { return x * __builtin_amdgcn_rcpf(1.f + __expf(-x)); }
__device__ __forceinline__ float sigm_f(float x) { return __builtin_amdgcn_rcpf(1.f + __expf(-x)); }
__device__ __forceinline__ f32x4 mfma32(bf16x8 a, bf16x8 b, f32x4 c) { return __builtin_amdgcn_mfma_f32_16x16x32_bf16(a, b, c, 0, 0, 0); }
__device__ __forceinline__ f32x4 mfma16(bf16x4 a, bf16x4 b, f32x4 c) { return __builtin_amdgcn_mfma_f32_16x16x16bf16_1k(a, b, c, 0, 0, 0); }
__device__ __forceinline__ bf16x4 pack4(f32x4 v) { u32x2 w; w.x = pk2(v[0], v[1]); w.y = pk2(v[2], v[3]); return __builtin_bit_cast(bf16x4, w); }
__device__ __forceinline__ u32x4 pack8(f32x4 a, f32x4 b) { u32x4 w; w.x = pk2(a[0], a[1]); w.y = pk2(a[2], a[3]); w.z = pk2(b[0], b[1]); w.w = pk2(b[2], b[3]); return w; }
__device__ __forceinline__ void unpack8(u32x4 w, f32x4& a, f32x4& b) { a = (f32x4){bflo(w.x), bfhi(w.x), bflo(w.y), bfhi(w.y)}; b = (f32x4){bflo(w.z), bfhi(w.z), bflo(w.w), bfhi(w.w)}; }
#define LDSWAIT() asm volatile("s_waitcnt lgkmcnt(0)" ::: "memory")

struct Ctx {
    const float *x, *g_mix, *w_in, *ret_norm_g, *dn_conv_w, *dn_a_log, *dn_dt_bias, *dn_norm_g, *w_ret_br, *w_dn_br, *w_o, *g_ffn, *w_up, *ffn_conv_w, *ffn_conv_b, *w_down, *g_final;
    float* out; unsigned char* ws; unsigned char* lds;
    int tid, lane, wave, bid, G, fr, fq;
};

template <class F> struct EpiRow8 {
    static constexpr bool PERM = true, AFTER_DRAIN = false; F f;
    __device__ __forceinline__ void operator()(const pg8::f32x4 (&acc)[2][2][4][2], const pg8::Unit& u, int wr, int wc, int fr, int fq) const {
#pragma unroll
        for (int ai = 0; ai < 2; ++ai)
#pragma unroll
            for (int m = 0; m < 4; ++m) { const int row = u.pm * 256 + ai * 128 + wr * 64 + m * 16 + fr;
#pragma unroll
                for (int bj = 0; bj < 2; ++bj) { const int col = u.pn * 256 + bj * 128 + wc * 32 + 8 * fq; f(row, col, acc[ai][bj][m][0], acc[ai][bj][m][1]); } }
    }
};

struct F1 {
    const float* r1; const float* rope; bf16 *rq, *rk, *rv, *dqkv, *halo;
    __device__ __forceinline__ void operator()(int row, int col, f32x4 v0, f32x4 v1) const {
        const float r = r1[row]; v0 = v0 * r; v1 = v1 * r;
        if (col < 1024) {
            const int t = row & (T - 1), p0 = (col & 63) >> 1;
            const f32x4 cs0 = *(const f32x4*)(rope + ((size_t)t * 32 + p0) * 2), cs1 = *(const f32x4*)(rope + ((size_t)t * 32 + p0) * 2 + 4);
            const float sc = col >= 512 ? 0.125f : 1.f;
            f32x4 o0, o1;
            o0[0] = (v0[0] * cs0[0] - v0[1] * cs0[1]) * sc; o0[1] = (v0[0] * cs0[1] + v0[1] * cs0[0]) * sc;
            o0[2] = (v0[2] * cs0[2] - v0[3] * cs0[3]) * sc; o0[3] = (v0[2] * cs0[3] + v0[3] * cs0[2]) * sc;
            o1[0] = (v1[0] * cs1[0] - v1[1] * cs1[1]) * sc; o1[1] = (v1[0] * cs1[1] + v1[1] * cs1[0]) * sc;
            o1[2] = (v1[2] * cs1[2] - v1[3] * cs1[3]) * sc; o1[3] = (v1[2] * cs1[3] + v1[3] * cs1[2]) * sc;
            bf16* dst = (col < 512 ? rq : rk) + (size_t)row * 512 + (col & 511);
            *(u32x4*)dst = pack8(o0, o1);
        } else if (col < 2048) {
            *(u32x4*)(rv + (size_t)row * 1024 + (col - 1024)) = pack8(v0, v1);
        } else {
            const int cc = col - 2048; const u32x4 w = pack8(v0, v1);
            *(u32x4*)(dqkv + (size_t)(cc >> 10) * ((size_t)M * 1024) + (size_t)row * 1024 + (cc & 1023)) = w;
            if ((row & 127) >= 125) *(u32x4*)(halo + ((size_t)(row >> 7) * 3 + ((row & 127) - 125)) * 3072 + cc) = w;
        }
    }
};
struct F5 {
    const float* r1; bf16 *rv, *dv, *sigr, *sigd;
    __device__ __forceinline__ void operator()(int row, int col, f32x4 v0, f32x4 v1) const {
        const float r = r1[row]; v0 = v0 * r; v1 = v1 * r;
        const int t = col >> 10, cc = col & 1023;
        if (t < 2) {
            bf16* p = (t == 0 ? rv : dv) + (size_t)row * 1024 + cc; f32x4 a, b; unpack8(*(const u32x4*)p, a, b);
#pragma unroll
            for (int e = 0; e < 4; ++e) { a[e] *= silu_f(v0[e]); b[e] *= silu_f(v1[e]); }
            *(u32x4*)p = pack8(a, b);
        } else {
            bf16* p = (t == 2 ? sigr : sigd) + (size_t)row * 1024 + cc; f32x4 a, b;
#pragma unroll
            for (int e = 0; e < 4; ++e) { a[e] = sigm_f(v0[e]); b[e] = sigm_f(v1[e]); }
            *(u32x4*)p = pack8(a, b);
        }
    }
};
struct F6a { bf16* sigr;
    __device__ __forceinline__ void operator()(int row, int col, f32x4 v0, f32x4 v1) const {
        bf16* p = sigr + (size_t)row * 1024 + col; f32x4 a, b; unpack8(*(const u32x4*)p, a, b); a = a * v0; b = b * v1; *(u32x4*)p = pack8(a, b); }
};
struct F6b { bf16* sigr; const bf16* sigd;
    __device__ __forceinline__ void operator()(int row, int col, f32x4 v0, f32x4 v1) const {
        bf16* p = sigr + (size_t)row * 1024 + col; f32x4 a, b, s0, s1; unpack8(*(const u32x4*)p, a, b); unpack8(*(const u32x4*)(sigd + (size_t)row * 1024 + col), s0, s1);
        a = a + s0 * v0; b = b + s1 * v1; *(u32x4*)p = pack8(a, b); }
};
template <bool BASE_F32> struct EpiRes {
    static constexpr bool PERM = true, AFTER_DRAIN = false;
    const float* basef; bf16* hb; float* ss;
    __device__ __forceinline__ void operator()(const pg8::f32x4 (&acc)[2][2][4][2], const pg8::Unit& u, int wr, int wc, int fr, int fq) const {
#pragma unroll
        for (int ai = 0; ai < 2; ++ai)
#pragma unroll
            for (int m = 0; m < 4; ++m) { const int row = u.pm * 256 + ai * 128 + wr * 64 + m * 16 + fr; float ssq = 0.f;
#pragma unroll
                for (int bj = 0; bj < 2; ++bj) { const int col = u.pn * 256 + bj * 128 + wc * 32 + 8 * fq; const size_t off = (size_t)row * 1024 + col;
                    f32x4 b0, b1;
                    if (BASE_F32) { b0 = *(const f32x4*)(basef + off); b1 = *(const f32x4*)(basef + off + 4); } else unpack8(*(const u32x4*)(hb + off), b0, b1);
                    const f32x4 h0 = b0 + acc[ai][bj][m][0], h1 = b1 + acc[ai][bj][m][1];
                    *(u32x4*)(hb + off) = pack8(h0, h1);
                    ssq += (h0[0] * h0[0] + h0[1] * h0[1]) + (h0[2] * h0[2] + h0[3] * h0[3]) + (h1[0] * h1[0] + h1[1] * h1[1]) + (h1[2] * h1[2] + h1[3] * h1[3]); }
                ssq += __shfl_xor(ssq, 16); ssq += __shfl_xor(ssq, 32);
                if (fq == 0) ss[(size_t)row * 16 + u.pn * 4 + wc] = ssq; }
    }
};
__device__ __forceinline__ float dpp_ror1(float v) { return __builtin_bit_cast(float, __builtin_amdgcn_mov_dpp(__builtin_bit_cast(int, v), 0x121, 0xf, 0xf, false)); }
__device__ __forceinline__ float dpp_ror2(float v) { return __builtin_bit_cast(float, __builtin_amdgcn_mov_dpp(__builtin_bit_cast(int, v), 0x122, 0xf, 0xf, false)); }
struct Epi8 {
    static constexpr bool PERM = true, AFTER_DRAIN = false;
    const float* ss; bf16 *act, *hbuf; const float *cw, *cb;
    __device__ __forceinline__ void operator()(const pg8::f32x4 (&acc)[2][2][4][2], const pg8::Unit& u, int wr, int wc, int fr, int fq) const {
#pragma unroll
        for (int bj = 0; bj < 2; ++bj) {
            const int col = u.pn * 256 + bj * 128 + wc * 32 + 8 * fq, j0 = col >> 1;
            f32x4 W0[3], W1[3], B0, B1;
            { f32x4 wa[3], wb[3];
#pragma unroll
              for (int k = 0; k < 3; ++k) { wa[k] = *(const f32x4*)(cw + (size_t)k * NUP + j0); wb[k] = *(const f32x4*)(cw + (size_t)k * NUP + DFF + j0);
                  W0[k] = (f32x4){wa[k][0], wb[k][0], wa[k][1], wb[k][1]}; W1[k] = (f32x4){wa[k][2], wb[k][2], wa[k][3], wb[k][3]}; }
              const f32x4 ba = *(const f32x4*)(cb + j0), bb = *(const f32x4*)(cb + DFF + j0);
              B0 = (f32x4){ba[0], bb[0], ba[1], bb[1]}; B1 = (f32x4){ba[2], bb[2], ba[3], bb[3]}; }
#pragma unroll
            for (int ai = 0; ai < 2; ++ai) {
                f32x4 pv0 = (f32x4){0.f, 0.f, 0.f, 0.f}, pv1 = pv0;
#pragma unroll
                for (int m = 0; m < 4; ++m) {
                    const int row = u.pm * 256 + ai * 128 + wr * 64 + m * 16 + fr;
                    const f32x4* sp = (const f32x4*)(ss + (size_t)row * 16); const f32x4 s4 = (sp[0] + sp[1]) + (sp[2] + sp[3]);
                    const float rr = rsqrtf(((s4[0] + s4[1]) + (s4[2] + s4[3])) * (1.f / 1024.f) + EPS);
                    const f32x4 c0 = acc[ai][bj][m][0] * rr, c1 = acc[ai][bj][m][1] * rr;
                    f32x4 p10, p11, p20, p21;
#pragma unroll
                    for (int e = 0; e < 4; ++e) {
                        p10[e] = dpp_ror1(fr == 15 ? pv0[e] : c0[e]); p11[e] = dpp_ror1(fr == 15 ? pv1[e] : c1[e]);
                        p20[e] = dpp_ror2(fr >= 14 ? pv0[e] : c0[e]); p21[e] = dpp_ror2(fr >= 14 ? pv1[e] : c1[e]); }
                    const f32x4 y0 = W0[0] * p20 + W0[1] * p10 + W0[2] * c0 + B0, y1 = W1[0] * p21 + W1[1] * p11 + W1[2] * c1 + B1;
                    const f32x4 o = (f32x4){silu_f(y0[0]) * y0[1], silu_f(y0[2]) * y0[3], silu_f(y1[0]) * y1[1], silu_f(y1[2]) * y1[3]};
                    const bool head = (m == 0) && (fr < 2);
                    if (!head) *(bf16x4*)(act + (size_t)row * DFF + j0) = pack4(o);
                    if (head || (m == 3 && fr >= 14)) { const int slot = (m == 0) ? fr : (fr - 12);
                        *(u32x4*)(hbuf + ((size_t)(row >> 6) * 4 + slot) * NUP + col) = pack8(c0, c1); }
                    pv0 = c0; pv1 = c1;
                    asm volatile("" ::: "memory");
                }
            }
        }
    }
};

__device__ __forceinline__ int win_srccol_old(int n) {
    if (n < 1024) return (n & ~63) + ((n & 63) >> 1) + 32 * (n & 1);
    if (n < 2048) return n;
    if (n < 5120) return n + 1024;
    if (n < 6144) return n - 5120 + 2048;
    if (n < 7168) return n;
    return n + 16;
}
__device__ __forceinline__ int win_srccol(int n) { return win_srccol_old(n < N5 ? n + N1 : n - N5); }
template <int MAP> __device__ __forceinline__ void transpose_item(const float* W, int K, int N, bf16* WT, const float* gk, float* scr, int item, int nblk, int lane) {
    const int kb = item / nblk, nb = item % nblk, k0 = 64 * kb, n0 = 32 * nb;
    const int nsrc = MAP == 1 ? win_srccol(n0 + (lane & 31)) : (MAP == 2 ? (((n0 + (lane & 31)) >> 1) + DFF * ((n0 + (lane & 31)) & 1)) : (n0 + (lane & 31)));
#pragma unroll 8
    for (int i = 0; i < 32; ++i) { const int kk = 2 * i + (lane >> 5); float v = W[(size_t)(k0 + kk) * N + nsrc]; if (gk) v *= gk[k0 + kk]; scr[kk * 33 + (lane & 31)] = v; }
    LDSWAIT();
    const int c = lane & 7;
#pragma unroll
    for (int j = 0; j < 4; ++j) { const int n = (lane >> 3) + 8 * j; const float* s = scr + (8 * c) * 33 + n;
        u32x4 o; o.x = pk2(s[0 * 33], s[1 * 33]); o.y = pk2(s[2 * 33], s[3 * 33]); o.z = pk2(s[4 * 33], s[5 * 33]); o.w = pk2(s[6 * 33], s[7 * 33]);
        *(u32x4*)(WT + (size_t)(n0 + n) * K + k0 + 8 * c) = o; }
    LDSWAIT();
}
__device__ __forceinline__ void phase0(const Ctx& c) {
    float* scr = (float*)(c.lds + c.wave * 16384);
    const int gw = c.bid * 8 + c.wave, ngw = c.G * 8;
    constexpr int I_IN = 16 * (NIN / 32);
    for (int it = gw; it < I_IN; it += ngw) transpose_item<1>(c.w_in, 1024, DIN, (bf16*)(c.ws + WS_WIN), nullptr, scr, it, NIN / 32, c.lane);
    float* rope = (float*)(c.ws + WS_ROPE);
    for (int i = c.bid * 512 + c.tid; i < T * 32; i += c.G * 512) { const int t = i >> 5, p = i & 31;
        const float inv = exp2f(-(float)p * 0.41524101186092029f); const float ang = (float)t * inv;
        const double rev = (double)ang * 0.15915494309189535; const float fr_ = (float)(rev - rint(rev));
        rope[2 * i] = __cosf(fr_ * 6.283185307179586f); rope[2 * i + 1] = __sinf(fr_ * 6.283185307179586f); }
    __syncthreads();
    bf16* wab = (bf16*)c.lds;
    for (int i = c.tid; i < 16 * 1024; i += 512) { const int n = i & 15, k = i >> 4; wab[n * 1032 + k] = f2bf(c.w_in[(size_t)k * DIN + 7168 + n]); }
    __syncthreads();
    bf16* Ux = (bf16*)(c.ws + WS_UX); float* r1 = (float*)(c.ws + WS_R1); float* gb = (float*)(c.ws + WS_GB);
    const int fr = c.fr, fq = c.fq;
    if ((c.wave & 1) == 0) for (int gi = c.bid * 4 + (c.wave >> 1); gi < M / 16; gi += c.G * 4) {
        const int row0 = gi * 16; const float* xr = c.x + (size_t)(row0 + fr) * 1024 + 8 * fq; bf16* ur = Ux + (size_t)(row0 + fr) * 1024 + 8 * fq;
        f32x4 acc = (f32x4){0.f, 0.f, 0.f, 0.f}; float ssq = 0.f;
#pragma unroll 4
        for (int kk = 0; kk < 32; ++kk) {
            f32x4 a0 = *(const f32x4*)(xr + 32 * kk), a1 = *(const f32x4*)(xr + 32 * kk + 4);
            const f32x4 g0 = *(const f32x4*)(c.g_mix + 32 * kk + 8 * fq), g1 = *(const f32x4*)(c.g_mix + 32 * kk + 8 * fq + 4);
            ssq += (a0[0] * a0[0] + a0[1] * a0[1]) + (a0[2] * a0[2] + a0[3] * a0[3]) + (a1[0] * a1[0] + a1[1] * a1[1]) + (a1[2] * a1[2] + a1[3] * a1[3]);
            a0 = a0 * g0; a1 = a1 * g1; const u32x4 pk = pack8(a0, a1);
            *(u32x4*)(ur + 32 * kk) = pk;
            const bf16x8 bfr = *(const bf16x8*)(wab + fr * 1032 + 32 * kk + 8 * fq);
            acc = mfma32(__builtin_bit_cast(bf16x8, pk), bfr, acc);
        }
        ssq += __shfl_xor(ssq, 16); ssq += __shfl_xor(ssq, 32);
        const float r = rsqrtf(ssq * (1.f / 1024.f) + EPS);
        if (fq == 0) r1[row0 + fr] = r;
#pragma unroll
        for (int j = 0; j < 4; ++j) { const float rj = __shfl(r, 4 * fq + j); const float val = acc[j] * rj; const int row = row0 + 4 * fq + j; float o;
            if (fr < 8) o = sigm_f(val);
            else { const int hh = fr - 8; const float z = val + c.dn_dt_bias[hh]; const float sp = z > 20.f ? z : log1pf(expf(z)); o = -expf(c.dn_a_log[hh]) * sp; }
            gb[(size_t)row * 16 + fr] = o; }
    }
}

constexpr int L_KS = 0, L_KT = 34816, L_VT = 68608, L_AB = 102400, L_TII = 137216, L_G = 141312;
__device__ __forceinline__ void dn_prep(const Ctx& c, int id) {
    const int bh = id >> 5, n = id & 31, b = bh >> 3, h = bh & 7, rowbase = b * T + n * CH;
    const int tid = c.tid, fr = c.fr, fq = c.fq, w = c.wave;
    bf16* ks = (bf16*)(c.lds + L_KS); bf16* kT = (bf16*)(c.lds + L_KT); bf16* vT = (bf16*)(c.lds + L_VT); bf16* Ab = (bf16*)(c.lds + L_AB); bf16* Tii = (bf16*)(c.lds + L_TII);
    float* Gs = (float*)(c.lds + L_G); float* Bs = Gs + 128; float* graw = Gs + 256;
    const float* gb = (const float*)(c.ws + WS_GB); float* Gc = (float*)(c.ws + WS_GC);
    bf16* dqkv = (bf16*)(c.ws + WS_DQ); const bf16* halo = (const bf16*)(c.ws + WS_HALO);
    if (tid < 128) { graw[tid] = gb[(size_t)(rowbase + tid) * 16 + 8 + h]; Bs[tid] = gb[(size_t)(rowbase + tid) * 16 + h]; }
    __syncthreads();
    if (tid < 128) {
        float s = graw[tid];
#pragma unroll
        for (int o = 1; o < 64; o <<= 1) { const float t = __shfl_up(s, o); if (c.lane >= o) s += t; }
        if (tid >= 64) { float tot = 0.f;
#pragma unroll 8
            for (int t = 0; t < 64; t += 4) { const f32x4 g4 = *(const f32x4*)(graw + t); tot += (g4[0] + g4[1]) + (g4[2] + g4[3]); }
            s += tot; }
        Gs[tid] = s; Gc[(size_t)id * 128 + tid] = s; }
    const int i = tid >> 2, cg = tid & 3;
    bf16* qs = Ab;
#ifndef DP_SKIP_CONV
    {
        const int cgp = tid & 15, strip = tid >> 4, col8 = 8 * cgp, i4 = 4 * strip;
#pragma unroll 1
        for (int t = 1; t < 3; ++t) {
            u32x4 raw[7];
#pragma unroll
            for (int k = 0; k < 7; ++k) { const int rr = i4 - 3 + k; u32x4 r = (u32x4){0u, 0u, 0u, 0u};
                if (rr >= 0) r = *(const u32x4*)(dqkv + (size_t)t * ((size_t)M * 1024) + (size_t)(rowbase + rr) * 1024 + h * 128 + col8);
                else if (n > 0) r = *(const u32x4*)(halo + ((size_t)(b * 32 + n - 1) * 3 + (rr + 3)) * 3072 + t * 1024 + h * 128 + col8);
                raw[k] = r; }
            f32x4 w0[4], w1[4];
#pragma unroll
            for (int k = 0; k < 4; ++k) { const float* wp = c.dn_conv_w + (size_t)k * 3072 + t * 1024 + h * 128 + col8; w0[k] = *(const f32x4*)wp; w1[k] = *(const f32x4*)(wp + 4); }
            f32x4 y0[4], y1[4]; float ssq[4];
#pragma unroll
            for (int r = 0; r < 4; ++r) { f32x4 a0 = (f32x4){0.f, 0.f, 0.f, 0.f}, a1 = a0;
#pragma unroll
                for (int k = 0; k < 4; ++k) { f32x4 x0, x1; unpack8(raw[r + k], x0, x1); a0 = a0 + x0 * w0[k]; a1 = a1 + x1 * w1[k]; }
                float sq = 0.f;
#pragma unroll
                for (int e = 0; e < 4; ++e) { a0[e] = silu_f(a0[e]); a1[e] = silu_f(a1[e]); sq += a0[e] * a0[e] + a1[e] * a1[e]; }
                y0[r] = a0; y1[r] = a1; ssq[r] = sq; }
            if (t < 2) {
#pragma unroll
                for (int r = 0; r < 4; ++r) { float sq = ssq[r]; sq += __shfl_xor(sq, 1); sq += __shfl_xor(sq, 2); sq += __shfl_xor(sq, 4); sq += __shfl_xor(sq, 8);
                    const float rn = rsqrtf(sq + EPS); y0[r] = y0[r] * rn; y1[r] = y1[r] * rn; }
            }
            u32x4 p[4];
#pragma unroll
            for (int r = 0; r < 4; ++r) p[r] = pack8(y0[r], y1[r]);
            if (t == 0) {
#pragma unroll
                for (int r = 0; r < 4; ++r) *(u32x4*)(qs + (i4 + r) * 136 + col8) = p[r];
            } else {
                if (t == 1) {
#pragma unroll
                    for (int r = 0; r < 4; ++r) *(u32x4*)(ks + (i4 + r) * 136 + col8) = p[r];
                }
                bf16* dT = (t == 1) ? kT : vT;
                const unsigned pw[4][4] = {{p[0].x, p[0].y, p[0].z, p[0].w}, {p[1].x, p[1].y, p[1].z, p[1].w}, {p[2].x, p[2].y, p[2].z, p[2].w}, {p[3].x, p[3].y, p[3].z, p[3].w}};
#pragma unroll
                for (int e = 0; e < 4; ++e) {
                    u32x2 lo, hi;
                    lo.x = (pw[0][e] & 0xffffu) | (pw[1][e] << 16); lo.y = (pw[2][e] & 0xffffu) | (pw[3][e] << 16);
                    hi.x = (pw[0][e] >> 16) | (pw[1][e] & 0xffff0000u); hi.y = (pw[2][e] >> 16) | (pw[3][e] & 0xffff0000u);
                    *(u32x2*)(dT + (col8 + 2 * e) * 132 + i4) = lo; *(u32x2*)(dT + (col8 + 2 * e + 1) * 132 + i4) = hi;
                }
            }
        }
    }
#endif
    __syncthreads();
#pragma unroll
    for (int s4 = 0; s4 < 4; ++s4) { const int idx = tid + 512 * s4, r = idx >> 4, c8 = (idx & 15) * 8;
        *(u32x4*)(dqkv + (size_t)M * 1024 + (size_t)(rowbase + r) * 1024 + h * 128 + c8) = *(const u32x4*)(ks + r * 136 + c8);
    }
    __syncthreads();
#ifndef DP_SKIP_KK
    {
        const int i0 = 16 * w; bf16x8 ai[4];
#pragma unroll
        for (int kk = 0; kk < 4; ++kk) ai[kk] = *(const bf16x8*)(ks + (i0 + fr) * 136 + 32 * kk + 8 * fq);
        const float Gi = Gs[i0 + fr], bi_ = Bs[i0 + fr];
        for (int jt = 0; jt <= w; ++jt) {
            f32x4 acc = (f32x4){0.f, 0.f, 0.f, 0.f};
#pragma unroll
            for (int kk = 0; kk < 4; ++kk) acc = mfma32(*(const bf16x8*)(ks + (16 * jt + fr) * 136 + 32 * kk + 8 * fq), ai[kk], acc);
            const f32x4 G4 = *(const f32x4*)(Gs + 16 * jt + 4 * fq); f32x4 o;
#pragma unroll
            for (int r = 0; r < 4; ++r) { const int j = 16 * jt + 4 * fq + r; o[r] = (i0 + fr > j) ? -bi_ * acc[r] * __expf(Gi - G4[r]) : 0.f; }
            *(bf16x4*)(Ab + (i0 + fr) * 136 + 16 * jt + 4 * fq) = pack4(o);
        }
    }
#endif
    __syncthreads();
#ifndef DP_SKIP_TII
    if (tid < 128) {
        const int blk = tid >> 4, cx = tid & 15; float xs[16];
#pragma unroll
        for (int r = 0; r < 16; ++r) {
            float s = (r == cx) ? 1.f : 0.f;
            const u32x4 ra = *(const u32x4*)(Ab + (16 * blk + r) * 136 + 16 * blk), rb = *(const u32x4*)(Ab + (16 * blk + r) * 136 + 16 * blk + 8);
            const unsigned rw[8] = {ra.x, ra.y, ra.z, ra.w, rb.x, rb.y, rb.z, rb.w};
#pragma unroll
            for (int s_ = 0; s_ < r; ++s_) { const float av = (s_ & 1) ? bfhi(rw[s_ >> 1]) : bflo(rw[s_ >> 1]); s += av * xs[s_]; }
            xs[r] = s; Tii[(blk * 16 + r) * 16 + cx] = f2bf(s);
            asm volatile("" ::: "memory");
        }
    }
#endif
#ifndef DP_SKIP_KD
    {
        const int d = tid >> 2, ig = tid & 3; const float Gl = Gs[127]; bf16* dst = (bf16*)(c.out) + (OUT_KDT / 2) + (size_t)id * 16384 + (size_t)((((d >> 4) * 4 + ig) * 64) + (d & 15)) * 8;
#pragma unroll
        for (int q = 0; q < 4; ++q) {
            const u32x2 r0 = *(const u32x2*)(kT + d * 132 + 32 * ig + 8 * q), r1 = *(const u32x2*)(kT + d * 132 + 32 * ig + 8 * q + 4);
            const f32x4 g0 = *(const f32x4*)(Gs + 32 * ig + 8 * q), g1 = *(const f32x4*)(Gs + 32 * ig + 8 * q + 4);
            f32x4 a = (f32x4){bflo(r0.x), bfhi(r0.x), bflo(r0.y), bfhi(r0.y)}, bb = (f32x4){bflo(r1.x), bfhi(r1.x), bflo(r1.y), bfhi(r1.y)};
#pragma unroll
            for (int e = 0; e < 4; ++e) { a[e] *= __expf(Gl - g0[e]); bb[e] *= __expf(Gl - g1[e]); }
            *(u32x4*)(dst + 128 * q) = pack8(a, bb);
        }
    }
#endif
    __syncthreads();
#ifndef DP_SKIP_SOLVE
    {
        const bool isk = w >= 4; const bf16* srcT = isk ? kT : vT; const int cb = (w & 3) * 32;
        bf16x4 X[8][2];
#pragma unroll
        for (int bi = 0; bi < 8; ++bi) {
            f32x4 bet = *(const f32x4*)(Bs + 16 * bi + 4 * fq);
            if (isk) { const f32x4 g4 = *(const f32x4*)(Gs + 16 * bi + 4 * fq); bet[0] *= __expf(g4[0]); bet[1] *= __expf(g4[1]); bet[2] *= __expf(g4[2]); bet[3] *= __expf(g4[3]); }
            f32x4 acc[2];
#pragma unroll
            for (int t = 0; t < 2; ++t) { const u32x2 raw = *(const u32x2*)(srcT + (cb + 16 * t + fr) * 132 + 16 * bi + 4 * fq);
                acc[t] = (f32x4){bflo(raw.x) * bet[0], bfhi(raw.x) * bet[1], bflo(raw.y) * bet[2], bfhi(raw.y) * bet[3]}; }
#pragma unroll
            for (int kb = 0; kb < ((DBG_SOLVE == 2 || DBG_SOLVE == 3) ? 0 : bi); ++kb) { const bf16x4 af = *(const bf16x4*)(Ab + (16 * bi + fr) * 136 + 16 * kb + 4 * fq);
                acc[0] = mfma16(af, X[kb][0], acc[0]); acc[1] = mfma16(af, X[kb][1], acc[1]); }
            const bf16x4 tf = *(const bf16x4*)(Tii + (bi * 16 + fr) * 16 + 4 * fq);
#pragma unroll
#if DBG_SOLVE == 1 || DBG_SOLVE == 3
            for (int t = 0; t < 2; ++t) X[bi][t] = pack4(acc[t]);
#else
            for (int t = 0; t < 2; ++t) X[bi][t] = pack4(mfma16(tf, pack4(acc[t]), (f32x4){0.f, 0.f, 0.f, 0.f}));
#endif
            asm volatile("" ::: "memory");
        }
        if (!isk) {
            bf16* dvp = (bf16*)(c.ws + WS_DV);
#pragma unroll
            for (int bi = 0; bi < 8; ++bi)
#pragma unroll
                for (int t = 0; t < 2; ++t) { const int cc = cb + 16 * t + fr, o = (((cc >> 4) * 8 + bi) * 16 + (cc & 15)) * 16 + 4 * fq;
                    *(bf16x4*)(dvp + (size_t)(rowbase + (o >> 7)) * 1024 + h * 128 + (o & 127)) = X[bi][t]; }
        } else {
#pragma unroll
            for (int bi = 0; bi < 8; ++bi)
#pragma unroll
                for (int t = 0; t < 2; ++t) { const u32x2 xx = __builtin_bit_cast(u32x2, X[bi][t]); const int col = cb + 16 * t + fr, r0 = 16 * bi + 4 * fq;
                    ks[(r0 + 0) * 136 + col] = (bf16)(xx.x & 0xffffu); ks[(r0 + 1) * 136 + col] = (bf16)(xx.x >> 16);
                    ks[(r0 + 2) * 136 + col] = (bf16)(xx.y & 0xffffu); ks[(r0 + 3) * 136 + col] = (bf16)(xx.y >> 16); }
        }
    }
#endif
    __syncthreads();
    {
        const int ii = tid >> 2, dg = tid & 3; bf16* dst = (bf16*)(c.out) + (OUT_W / 2) + (size_t)id * 16384 + (size_t)((((ii >> 4) * 4 + dg) * 64) + (ii & 15)) * 8;
#pragma unroll
        for (int q = 0; q < 4; ++q) *(u32x4*)(dst + 128 * q) = *(const u32x4*)(ks + ii * 136 + 32 * dg + 8 * q);
    }
    __syncthreads();
}
__device__ __forceinline__ void strip_transpose_store(bf16* dT, int ld, int c8, int j4, const u32x4 (&p)[4]) {
    const unsigned pw[4][4] = {{p[0].x, p[0].y, p[0].z, p[0].w}, {p[1].x, p[1].y, p[1].z, p[1].w}, {p[2].x, p[2].y, p[2].z, p[2].w}, {p[3].x, p[3].y, p[3].z, p[3].w}};
#pragma unroll
    for (int e = 0; e < 4; ++e) { u32x2 lo, hi;
        lo.x = (pw[0][e] & 0xffffu) | (pw[1][e] << 16); lo.y = (pw[2][e] & 0xffffu) | (pw[3][e] << 16);
        hi.x = (pw[0][e] >> 16) | (pw[1][e] & 0xffff0000u); hi.y = (pw[2][e] >> 16) | (pw[3][e] & 0xffff0000u);
        *(u32x2*)(dT + (c8 + 2 * e) * ld + j4) = lo; *(u32x2*)(dT + (c8 + 2 * e + 1) * ld + j4) = hi; }
}
__device__ __forceinline__ float ret_logg(int h) { return log1pf(-exp2f(-5.f - (float)h)); }
__device__ __forceinline__ void ret_kv(const Ctx& c, int id) {
    const int bh = id >> 5, n = id & 31, b = bh >> 3, h = bh & 7, rowbase = b * T + n * CH;
    const int tid = c.tid, fr = c.fr, fq = c.fq, w = c.wave;
    bf16* kT2 = (bf16*)c.lds; bf16* vT2 = (bf16*)(c.lds + 17408);
    const bf16* rk = (const bf16*)(c.ws + WS_RK); const bf16* rv = (const bf16*)(c.ws + WS_RV);
    const float lg = ret_logg(h);
    { const int c8 = 8 * (tid & 15), j4 = 4 * (tid >> 4); u32x4 p[4];
#pragma unroll
      for (int r = 0; r < 4; ++r) p[r] = *(const u32x4*)(rv + (size_t)(rowbase + j4 + r) * 1024 + h * 128 + c8);
      strip_transpose_store(vT2, 136, c8, j4, p); }
    if (tid < 256) { const int c8 = 8 * (tid & 7), j4 = 4 * (tid >> 3); u32x4 p[4];
#pragma unroll
      for (int r = 0; r < 4; ++r) { f32x4 a, bb; unpack8(*(const u32x4*)(rk + (size_t)(rowbase + j4 + r) * 512 + h * 64 + c8), a, bb); const float z = __expf(lg * (float)(127 - (j4 + r))); p[r] = pack8(a * z, bb * z); }
      strip_transpose_store(kT2, 136, c8, j4, p); }
    __syncthreads();
    bf16* kv = (bf16*)(c.ws + WS_KV) + (size_t)id * 8192;
#pragma unroll
    for (int dt = 0; dt < 4; ++dt) { f32x4 acc = (f32x4){0.f, 0.f, 0.f, 0.f};
#pragma unroll
        for (int kk = 0; kk < 4; ++kk) acc = mfma32(*(const bf16x8*)(kT2 + (16 * dt + fr) * 136 + 32 * kk + 8 * fq), *(const bf16x8*)(vT2 + (16 * w + fr) * 136 + 32 * kk + 8 * fq), acc);
        *(bf16x4*)(kv + (16 * w + fr) * 64 + 16 * dt + 4 * fq) = pack4(acc); }
    __syncthreads();
}

__device__ __forceinline__ void phase3(const Ctx& c) {
    const int fr = c.fr, fq = c.fq, w = c.wave, tid = c.tid;
    bf16* Sl = (bf16*)c.lds; bf16* Vl = (bf16*)(c.lds + 4352);
    const bf16* Wp0 = (const bf16*)(c.out) + (OUT_W / 2); const bf16* Kp0 = (const bf16*)(c.out) + (OUT_KDT / 2);
    bf16* dvp = (bf16*)(c.ws + WS_DV); bf16* snp = (bf16*)(c.ws + WS_SN); const float* Gc = (const float*)(c.ws + WS_GC);
    for (int wi = c.bid; wi < 256; wi += c.G) {
        const int xq = wi & 7, yq = wi >> 3, slice = yq & 7, bh = xq + 8 * (yq >> 3), b = bh >> 3, h = bh & 7;
        for (int i = tid; i < 16 * 136 / 2; i += 512) ((unsigned*)Sl)[i] = 0u;
        __syncthreads();
        f32x4 S = (f32x4){0.f, 0.f, 0.f, 0.f};
        const size_t woff = (size_t)w * 2048 + (size_t)c.lane * 8;
        const bf16* Wb = Wp0 + (size_t)(bh * 32) * 16384 + woff; const bf16* Kb = Kp0 + (size_t)(bh * 32) * 16384 + woff;
        const int o3 = ((slice * 8 + w) * 16 + fr) * 16 + 4 * fq;
        bf16* ub = dvp + (size_t)(b * T + (o3 >> 7)) * 1024 + h * 128 + (o3 & 127);
        bf16* sb = snp + (size_t)(bh * 32) * 16384 + o3;
        const float* gl = Gc + (size_t)(bh * 32) * 128 + 127;
        bf16x8 wR[4][4], kR[4][4]; bf16x4 uR[4]; float dR[4];
#define P3_LOAD(slot, n_) do { _Pragma("unroll") for (int kk = 0; kk < 4; ++kk) { wR[slot][kk] = *(const bf16x8*)(Wb + (size_t)(n_) * 16384 + 512 * kk); kR[slot][kk] = *(const bf16x8*)(Kb + (size_t)(n_) * 16384 + 512 * kk); } \
            uR[slot] = *(const bf16x4*)(ub + (size_t)(n_) * CH * 1024); dR[slot] = gl[(size_t)(n_) * 128]; } while (0)
#define P3_BAR() do { asm volatile("s_waitcnt lgkmcnt(0)" ::: "memory"); __builtin_amdgcn_s_barrier(); asm volatile("" ::: "memory"); } while (0)
#define P3_STEP(slot, n_) do { \
            *(bf16x4*)(sb + (size_t)(n_) * 16384) = pack4(S); \
            f32x4 accA = (f32x4){0.f, 0.f, 0.f, 0.f}, accB = accA; \
            accA = mfma32(wR[slot][0], *(const bf16x8*)(Sl + fr * 136 + 8 * fq), accA); accB = mfma32(wR[slot][1], *(const bf16x8*)(Sl + fr * 136 + 32 + 8 * fq), accB); \
            accA = mfma32(wR[slot][2], *(const bf16x8*)(Sl + fr * 136 + 64 + 8 * fq), accA); accB = mfma32(wR[slot][3], *(const bf16x8*)(Sl + fr * 136 + 96 + 8 * fq), accB); \
            const u32x2 ur = __builtin_bit_cast(u32x2, uR[slot]); \
            const f32x4 vn = (f32x4){bflo(ur.x) - (accA[0] + accB[0]), bfhi(ur.x) - (accA[1] + accB[1]), bflo(ur.y) - (accA[2] + accB[2]), bfhi(ur.y) - (accA[3] + accB[3])}; \
            const bf16x4 vb = pack4(vn); \
            *(bf16x4*)(ub + (size_t)(n_) * CH * 1024) = vb; \
            *(bf16x4*)(Vl + fr * 136 + 16 * w + 4 * fq) = vb; \
            P3_BAR(); \
            f32x4 acC = (f32x4){0.f, 0.f, 0.f, 0.f}, acD = acC; \
            acC = mfma32(kR[slot][0], *(const bf16x8*)(Vl + fr * 136 + 8 * fq), acC); acD = mfma32(kR[slot][1], *(const bf16x8*)(Vl + fr * 136 + 32 + 8 * fq), acD); \
            acC = mfma32(kR[slot][2], *(const bf16x8*)(Vl + fr * 136 + 64 + 8 * fq), acC); acD = mfma32(kR[slot][3], *(const bf16x8*)(Vl + fr * 136 + 96 + 8 * fq), acD); \
            S = S * __expf(dR[slot]) + (acC + acD); \
            *(bf16x4*)(Sl + fr * 136 + 16 * w + 4 * fq) = pack4(S); \
            P3_BAR(); } while (0)
        P3_LOAD(0, 0); P3_LOAD(1, 1); P3_LOAD(2, 2); P3_LOAD(3, 3);
#pragma unroll
        for (int n4 = 0; n4 < NCH; n4 += 4) {
            const int np = (n4 + 4 < NCH) ? 4 : 0;
            P3_STEP(0, n4);     P3_LOAD(0, n4 + np);
            P3_STEP(1, n4 + 1); P3_LOAD(1, n4 + np + (np ? 1 : 0));
            P3_STEP(2, n4 + 2); P3_LOAD(2, n4 + np + (np ? 2 : 0));
            P3_STEP(3, n4 + 3); P3_LOAD(3, n4 + np + (np ? 3 : 0));
        }
#undef P3_LOAD
#undef P3_STEP
#undef P3_BAR
        __syncthreads();
    }
    for (int gid = c.bid * 512 + tid; gid < 32 * 4096; gid += c.G * 512) {
        const int bh = gid >> 12, e = gid & 4095, h = bh & 7; const float decay = __expf(128.f * ret_logg(h));
        unsigned* p = (unsigned*)(c.ws + WS_KV) + (size_t)(bh * 32) * 4096 + e; float s0 = 0.f, s1 = 0.f;
#pragma unroll 8
        for (int n = 0; n < NCH; ++n) { const unsigned raw = p[(size_t)n * 4096]; p[(size_t)n * 4096] = pk2(s0, s1); s0 = s0 * decay + bflo(raw); s1 = s1 * decay + bfhi(raw); }
    }
}

struct DnPre { u32x4 kk[4], vv[4], ss[4], qraw[7]; float g; };
__device__ __forceinline__ void dn_out_load(const Ctx& c, int id, DnPre& p) {
    const int bh = id >> 5, n = id & 31, b = bh >> 3, h = bh & 7, rowbase = b * T + n * CH; const int tid = c.tid, fr = c.fr, fq = c.fq, w = c.wave;
    const bf16* dq = (const bf16*)(c.ws + WS_DQ); const bf16* dk = (const bf16*)(c.ws + WS_DK); const bf16* dv = (const bf16*)(c.ws + WS_DV); const bf16* sn = (const bf16*)(c.ws + WS_SN) + (size_t)id * 16384;
#pragma unroll
    for (int s = 0; s < 4; ++s) { const int idx = tid + 512 * s, r = idx >> 4, c8 = (idx & 15) * 8;
        const int o = 8 * idx;
        p.kk[s] = *(const u32x4*)(dk + (size_t)(rowbase + r) * 1024 + h * 128 + c8); p.vv[s] = *(const u32x4*)(dv + (size_t)(rowbase + (o >> 7)) * 1024 + h * 128 + (o & 127)); p.ss[s] = *(const u32x4*)(sn + o); }
    { const bf16* halo = (const bf16*)(c.ws + WS_HALO); const int col8 = 8 * (tid & 15), i4 = 4 * (tid >> 4);
#pragma unroll
      for (int k = 0; k < 7; ++k) { const int rr = i4 - 3 + k; u32x4 r = (u32x4){0u, 0u, 0u, 0u};
          if (rr >= 0) r = *(const u32x4*)(dq + (size_t)(rowbase + rr) * 1024 + h * 128 + col8);
          else if (n > 0) r = *(const u32x4*)(halo + ((size_t)(b * 32 + n - 1) * 3 + (rr + 3)) * 3072 + h * 128 + col8);
          p.qraw[k] = r; } }
    p.g = (tid < 128) ? ((const float*)(c.ws + WS_GC))[(size_t)id * 128 + tid] : 0.f;
}
__device__ __forceinline__ void dn_out(const Ctx& c, int id, int next_id, DnPre& p) {
    const int bh = id >> 5, n = id & 31, b = bh >> 3, h = bh & 7, rowbase = b * T + n * CH;
    const int tid = c.tid, fr = c.fr, fq = c.fq, w = c.wave;
    bf16* ksl = (bf16*)c.lds; bf16* snl = (bf16*)(c.lds + 34816); bf16* vl = (bf16*)(c.lds + 69632); float* Gs = (float*)(c.lds + 104448);
    bf16* dv = (bf16*)(c.ws + WS_DV);
#pragma unroll
    for (int s = 0; s < 4; ++s) { const int idx = tid + 512 * s, r = idx >> 4, c8 = (idx & 15) * 8;
        const int o = 8 * idx, cT = (((o >> 11) & 7) << 4) | ((o >> 4) & 15), iT = (((o >> 8) & 7) << 4) | (o & 15);
        *(u32x4*)(ksl + r * 136 + c8) = p.kk[s]; *(u32x4*)(vl + cT * 136 + iT) = p.vv[s]; *(u32x4*)(snl + cT * 136 + iT) = p.ss[s]; }
    if (tid < 128) Gs[tid] = p.g;
    bf16* qsl = (bf16*)(c.lds + 104960);
    { const int col8 = 8 * (tid & 15), i4 = 4 * (tid >> 4);
      f32x4 w0[4], w1[4];
#pragma unroll
      for (int k = 0; k < 4; ++k) { const float* wp = c.dn_conv_w + (size_t)k * 3072 + h * 128 + col8; w0[k] = *(const f32x4*)wp; w1[k] = *(const f32x4*)(wp + 4); }
#pragma unroll
      for (int r = 0; r < 4; ++r) { f32x4 a0 = (f32x4){0.f, 0.f, 0.f, 0.f}, a1 = a0;
#pragma unroll
          for (int k = 0; k < 4; ++k) { f32x4 x0, x1; unpack8(p.qraw[r + k], x0, x1); a0 = a0 + x0 * w0[k]; a1 = a1 + x1 * w1[k]; }
          float sq = 0.f;
#pragma unroll
          for (int e = 0; e < 4; ++e) { a0[e] = silu_f(a0[e]); a1[e] = silu_f(a1[e]); sq += a0[e] * a0[e] + a1[e] * a1[e]; }
          sq += __shfl_xor(sq, 1); sq += __shfl_xor(sq, 2); sq += __shfl_xor(sq, 4); sq += __shfl_xor(sq, 8);
          const float rn = rsqrtf(sq + EPS);
          *(u32x4*)(qsl + (i4 + r) * 136 + col8) = pack8(a0 * rn, a1 * rn); } }
    __syncthreads();
    dn_out_load(c, next_id, p);
    const int i0 = 16 * w, i = i0 + fr; const float scale = 0.08838834764831845f;
    bf16x8 qA[4];
#pragma unroll
    for (int kk = 0; kk < 4; ++kk) qA[kk] = *(const bf16x8*)(qsl + i * 136 + 32 * kk + 8 * fq);
    const float Gi = Gs[i], rowsc = __expf(Gi) * scale;
    f32x4 O[8];
#pragma unroll
    for (int ct = 0; ct < 8; ++ct) { f32x4 acc = (f32x4){0.f, 0.f, 0.f, 0.f};
#pragma unroll
        for (int kk = 0; kk < 4; ++kk) acc = mfma32(*(const bf16x8*)(snl + (16 * ct + fr) * 136 + 32 * kk + 8 * fq), qA[kk], acc);
        O[ct] = acc * rowsc; }
    for (int jt = 0; jt <= w; ++jt) {
        f32x4 p = (f32x4){0.f, 0.f, 0.f, 0.f};
#pragma unroll
        for (int kk = 0; kk < 4; ++kk) p = mfma32(*(const bf16x8*)(ksl + (16 * jt + fr) * 136 + 32 * kk + 8 * fq), qA[kk], p);
        const f32x4 G4 = *(const f32x4*)(Gs + 16 * jt + 4 * fq);
#pragma unroll
        for (int r = 0; r < 4; ++r) { const int j = 16 * jt + 4 * fq + r; p[r] = (i >= j) ? p[r] * scale * __expf(Gi - G4[r]) : 0.f; }
        const bf16x4 pb = pack4(p);
#pragma unroll
        for (int ct = 0; ct < 8; ++ct) O[ct] = mfma16(*(const bf16x4*)(vl + (16 * ct + fr) * 136 + 16 * jt + 4 * fq), pb, O[ct]);
    }
    float ssq = 0.f;
#pragma unroll
    for (int ct = 0; ct < 8; ++ct) ssq += (O[ct][0] * O[ct][0] + O[ct][1] * O[ct][1]) + (O[ct][2] * O[ct][2] + O[ct][3] * O[ct][3]);
    ssq += __shfl_xor(ssq, 16); ssq += __shfl_xor(ssq, 32);
    const float rstd = rsqrtf(ssq * (1.f / 128.f) + EPS);
#pragma unroll
    for (int ct = 0; ct < 8; ++ct) { const int cc = 16 * ct + 4 * fq; const f32x4 g4 = *(const f32x4*)(c.dn_norm_g + cc);
        *(bf16x4*)(dv + (size_t)(rowbase + i) * 1024 + h * 128 + cc) = pack4(O[ct] * rstd * g4); }
    __syncthreads();
}
__device__ __forceinline__ void ret_out(const Ctx& c, int id) {
    const int bh = id >> 5, n = id & 31, b = bh >> 3, h = bh & 7, rowbase = b * T + n * CH;
    const int tid = c.tid, fr = c.fr, fq = c.fq, w = c.wave;
    bf16* ksl = (bf16*)c.lds; bf16* snl = (bf16*)(c.lds + 18432); bf16* vl = (bf16*)(c.lds + 36864);
    const bf16* rq = (const bf16*)(c.ws + WS_RQ); const bf16* rk = (const bf16*)(c.ws + WS_RK); bf16* rv = (bf16*)(c.ws + WS_RV); const bf16* sp = (const bf16*)(c.ws + WS_KV) + (size_t)id * 8192;
#pragma unroll
    for (int s = 0; s < 2; ++s) { const int idx = tid + 512 * s, r = idx >> 3, c8 = (idx & 7) * 8;
        *(u32x4*)(ksl + r * 72 + c8) = *(const u32x4*)(rk + (size_t)(rowbase + r) * 512 + h * 64 + c8);
        *(u32x4*)(snl + r * 72 + c8) = *(const u32x4*)(sp + r * 64 + c8); }
    { const int c8 = 8 * (tid & 15), j4 = 4 * (tid >> 4); u32x4 p[4];
#pragma unroll
      for (int r = 0; r < 4; ++r) p[r] = *(const u32x4*)(rv + (size_t)(rowbase + j4 + r) * 1024 + h * 128 + c8);
      strip_transpose_store(vl, 136, c8, j4, p); }
    __syncthreads();
    const int i0 = 16 * w, i = i0 + fr; const float lg = ret_logg(h);
    bf16x8 qA[2];
#pragma unroll
    for (int kk = 0; kk < 2; ++kk) qA[kk] = *(const bf16x8*)(rq + (size_t)(rowbase + i) * 512 + h * 64 + 32 * kk + 8 * fq);
    const float xi = __expf(lg * (float)(i + 1));
    f32x4 O[8];
#pragma unroll
    for (int ct = 0; ct < 8; ++ct) { f32x4 acc = (f32x4){0.f, 0.f, 0.f, 0.f};
#pragma unroll
        for (int kk = 0; kk < 2; ++kk) acc = mfma32(*(const bf16x8*)(snl + (16 * ct + fr) * 72 + 32 * kk + 8 * fq), qA[kk], acc);
        O[ct] = acc * xi; }
    for (int jt = 0; jt <= w; ++jt) {
        f32x4 p = (f32x4){0.f, 0.f, 0.f, 0.f};
#pragma unroll
        for (int kk = 0; kk < 2; ++kk) p = mfma32(*(const bf16x8*)(ksl + (16 * jt + fr) * 72 + 32 * kk + 8 * fq), qA[kk], p);
#pragma unroll
        for (int r = 0; r < 4; ++r) { const int j = 16 * jt + 4 * fq + r; p[r] = (i >= j) ? p[r] * __expf(lg * (float)(i - j)) : 0.f; }
        const bf16x4 pb = pack4(p);
#pragma unroll
        for (int ct = 0; ct < 8; ++ct) O[ct] = mfma16(*(const bf16x4*)(vl + (16 * ct + fr) * 136 + 16 * jt + 4 * fq), pb, O[ct]);
    }
    float sm = 0.f;
#pragma unroll
    for (int ct = 0; ct < 8; ++ct) sm += (O[ct][0] + O[ct][1]) + (O[ct][2] + O[ct][3]);
    sm += __shfl_xor(sm, 16); sm += __shfl_xor(sm, 32);
    const float mu = sm * (1.f / 128.f); float vs = 0.f;
#pragma unroll
    for (int ct = 0; ct < 8; ++ct) { O[ct] = O[ct] - mu; vs += (O[ct][0] * O[ct][0] + O[ct][1] * O[ct][1]) + (O[ct][2] * O[ct][2] + O[ct][3] * O[ct][3]); }
    vs += __shfl_xor(vs, 16); vs += __shfl_xor(vs, 32);
    const float rstd = rsqrtf(vs * (1.f / 128.f) + GN_EPS);
#pragma unroll
    for (int ct = 0; ct < 8; ++ct) { const int cc = 16 * ct + 4 * fq; const f32x4 g4 = *(const f32x4*)(c.ret_norm_g + h * 128 + cc);
        *(bf16x4*)(rv + (size_t)(rowbase + i) * 1024 + h * 128 + cc) = pack4(O[ct] * rstd * g4); }
    __syncthreads();
}

__device__ __forceinline__ void ffn_fixup(const Ctx& c, int pm) {
    bf16* act = (bf16*)(c.ws + WS_ACT); const bf16* hbuf = (const bf16*)(c.ws + WS_HBUF);
    constexpr int NJ4 = DFF / 4;
    for (int idx = c.tid; idx < 8 * NJ4; idx += 512) {
        const int j0 = (idx % NJ4) * 4, gr = idx / NJ4, g = 4 * pm + (gr >> 1), r = gr & 1, col = 2 * j0;
        const bool first = ((g * 64) & (T - 1)) == 0;
        u32x4 u0, u1 = (u32x4){0u, 0u, 0u, 0u}, u2 = u1;
        u0 = *(const u32x4*)(hbuf + ((size_t)g * 4 + r) * NUP + col);
        if (r == 1) { u1 = *(const u32x4*)(hbuf + ((size_t)g * 4 + 0) * NUP + col); if (!first) u2 = *(const u32x4*)(hbuf + ((size_t)(g - 1) * 4 + 3) * NUP + col); }
        else if (!first) { u1 = *(const u32x4*)(hbuf + ((size_t)(g - 1) * 4 + 3) * NUP + col); u2 = *(const u32x4*)(hbuf + ((size_t)(g - 1) * 4 + 2) * NUP + col); }
        f32x4 c0, c1, p10, p11, p20, p21; unpack8(u0, c0, c1); unpack8(u1, p10, p11); unpack8(u2, p20, p21);
        f32x4 wa[3], wb[3];
#pragma unroll
        for (int k = 0; k < 3; ++k) { wa[k] = *(const f32x4*)(c.ffn_conv_w + (size_t)k * NUP + j0); wb[k] = *(const f32x4*)(c.ffn_conv_w + (size_t)k * NUP + DFF + j0); }
        const f32x4 ba = *(const f32x4*)(c.ffn_conv_b + j0), bb = *(const f32x4*)(c.ffn_conv_b + DFF + j0);
        const f32x4 xa = (f32x4){c0[0], c0[2], c1[0], c1[2]}, xb = (f32x4){c0[1], c0[3], c1[1], c1[3]};
        const f32x4 xa1 = (f32x4){p10[0], p10[2], p11[0], p11[2]}, xb1 = (f32x4){p10[1], p10[3], p11[1], p11[3]};
        const f32x4 xa2 = (f32x4){p20[0], p20[2], p21[0], p21[2]}, xb2 = (f32x4){p20[1], p20[3], p21[1], p21[3]};
        const f32x4 ya = wa[0] * xa2 + wa[1] * xa1 + wa[2] * xa + ba, yb = wb[0] * xb2 + wb[1] * xb1 + wb[2] * xb + bb;
        f32x4 o;
#pragma unroll
        for (int e = 0; e < 4; ++e) o[e] = silu_f(ya[e]) * yb[e];
        *(bf16x4*)(act + (size_t)(g * 64 + r) * DFF + j0) = pack4(o);
    }
}

#define XB_TMO      128
#define XB_XCNT(j)  (256  + 64 * (j))
#define XB_XSUB(j)  (1280 + 64 * (j))
#define XB_XGEN(j)  (2304 + 64 * (j))
#define XB_TOP      3328
#define XB_TOPGEN   3392
#define XCD_BAR_WORDS 3456
#define XB_SPIN_CAP (1u << 18)

__device__ __forceinline__ unsigned xb_ld(unsigned* p)              { return __hip_atomic_load(p, __ATOMIC_RELAXED, __HIP_MEMORY_SCOPE_AGENT); }
__device__ __forceinline__ unsigned xb_add(unsigned* p, unsigned v) { return __hip_atomic_fetch_add(p, v, __ATOMIC_RELAXED, __HIP_MEMORY_SCOPE_AGENT); }
__device__ __forceinline__ unsigned xb_xcc_id() { return (unsigned)__builtin_amdgcn_s_getreg((3 << 11) | 20) & 0xFu; }
#define XB_SPIN(cond, bar) do { unsigned _sp = 0; while (cond) { __builtin_amdgcn_s_sleep(1); \
    if ((++_sp & 255u) == 0u) { if (xb_ld(&(bar)[XB_TMO])) break; if (_sp > XB_SPIN_CAP) { atomicAdd(&(bar)[XB_TMO], 1u); break; } } } } while (0)

struct XcdBarrier {
    unsigned* bar; unsigned x;
    volatile PG8_LAS unsigned* st;
};

__device__ __forceinline__ XcdBarrier xcd_barrier_post(unsigned* bar, volatile PG8_LAS unsigned* st) {
    XcdBarrier b; b.bar = bar; b.x = xb_xcc_id(); b.st = st;
    if (threadIdx.x == 0) (void)xb_add(&bar[XB_XCNT(b.x)], 1u);
    return b;
}
__device__ __forceinline__ void xcd_barrier_complete(unsigned* bar, unsigned x, unsigned& nloc, unsigned& nx) {
    const unsigned G = gridDim.x * gridDim.y * gridDim.z;
    unsigned sum, cnt, mine, sp = 0u;
    for (;;) {
        sum = 0u; cnt = 0u; mine = 0u;
#pragma unroll
        for (unsigned j = 0; j < 16; ++j) { const unsigned c = xb_ld(&bar[XB_XCNT(j)]); sum += c; cnt += (c > 0u) ? 1u : 0u; mine = (j == x) ? c : mine; }
        if (sum == G) break;
        __builtin_amdgcn_s_sleep(1);
        if ((++sp & 255u) == 0u) { if (xb_ld(&bar[XB_TMO])) break; if (sp > XB_SPIN_CAP) { atomicAdd(&bar[XB_TMO], 1u); break; } }
    }
    nloc = mine > 0u ? mine : 1u; nx = cnt > 0u ? cnt : 1u;
}

__device__ __forceinline__ void xcd_barrier(const XcdBarrier& b) {
    asm volatile("s_waitcnt vmcnt(0)" ::: "memory");
    __syncthreads();
    if (threadIdx.x == 0) {
        unsigned* bar = b.bar;
        __builtin_amdgcn_s_waitcnt(0);
        unsigned nloc = b.st[0], nx = b.st[1];
        if (nloc == 0u) { xcd_barrier_complete(bar, b.x, nloc, nx); b.st[0] = nloc; b.st[1] = nx; }
        const unsigned old = xb_add(&bar[XB_XSUB(b.x)], 1u);
        const unsigned gen = old / nloc;
        if (old + 1u == (gen + 1u) * nloc) {
            __builtin_amdgcn_fence(__ATOMIC_RELEASE, "agent");
            asm volatile("s_waitcnt vmcnt(0)" ::: "memory");
            const unsigned og = xb_add(&bar[XB_TOP], 1u);
            const unsigned tg = og / nx;
            if (og + 1u == (tg + 1u) * nx) xb_add(&bar[XB_TOPGEN], 1u);
            else XB_SPIN(xb_ld(&bar[XB_TOPGEN]) == tg, bar);
            __builtin_amdgcn_fence(__ATOMIC_ACQUIRE, "agent");
            xb_add(&bar[XB_XGEN(b.x)], 1u);
            asm volatile("s_waitcnt vmcnt(0)" ::: "memory");
        } else {
            XB_SPIN(xb_ld(&bar[XB_XGEN(b.x)]) == gen, bar);
            __builtin_amdgcn_fence(__ATOMIC_ACQUIRE, "agent");
            asm volatile("s_waitcnt vmcnt(0)" ::: "memory");
        }
    }
    __syncthreads();
}

struct PairOrder {
    pg8::StaticOrder base;
    __device__ bool next(int i, pg8::Unit& u) const { if (!base.next(i >> 1, u)) return false; if (i & 1) { u.pm += 192; u.pn += 4; } return true; }
    __device__ __forceinline__ void a_ready(const pg8::Unit&) const {}
    __device__ __forceinline__ void done(const pg8::Unit&) const {}
};
struct Epi6 {
    static constexpr bool PERM = true, AFTER_DRAIN = false; bf16* sigr; const bf16* sigd;
    __device__ __forceinline__ void operator()(const pg8::f32x4 (&acc)[2][2][4][2], const pg8::Unit& u, int wr, int wc, int fr, int fq) const {
        const bool second = u.pn >= 4; const int pm = second ? u.pm - 192 : u.pm, pn = second ? u.pn - 4 : u.pn;
#pragma unroll
        for (int ai = 0; ai < 2; ++ai)
#pragma unroll
            for (int m = 0; m < 4; ++m) { const int row = pm * 256 + ai * 128 + wr * 64 + m * 16 + fr;
#pragma unroll
                for (int bj = 0; bj < 2; ++bj) { const int col = pn * 256 + bj * 128 + wc * 32 + 8 * fq; bf16* p = sigr + (size_t)row * 1024 + col;
                    f32x4 a, b; unpack8(*(const u32x4*)p, a, b);
                    if (!second) { a = a * acc[ai][bj][m][0]; b = b * acc[ai][bj][m][1]; }
                    else { f32x4 s0, s1; unpack8(*(const u32x4*)(sigd + (size_t)row * 1024 + col), s0, s1); a = a + s0 * acc[ai][bj][m][0]; b = b + s1 * acc[ai][bj][m][1]; }
                    *(u32x4*)p = pack8(a, b); } }
    }
};
template <int K> __device__ __forceinline__ void run_phase(const Ctx& c, unsigned char* lds, PG8_LAS unsigned char* ldsl, unsigned char* ws, bf16* outb) {

    if constexpr (K == 0) phase0(c);
    if constexpr (K == 1) {
        pg8::Gemm g{(const bf16*)(ws + WS_UX), (const bf16*)(ws + WS_WIN) + (size_t)N5 * 1024, M, N1, 1024, 1024, 1024}; pg8::StaticOrder S; S.init(M, N1, c.G, c.bid);
        EpiRow8<F1> E{F1{(const float*)(ws + WS_R1), (const float*)(ws + WS_ROPE), (bf16*)(ws + WS_RQ), (bf16*)(ws + WS_RK), (bf16*)(ws + WS_RV), (bf16*)(ws + WS_DQ), (bf16*)(ws + WS_HALO)}};
        pg8::gemm_phase<EpiRow8<F1>, pg8::StaticOrder, true, true>(ldsl, g, S, E);
    }
    if constexpr (K == 2) {
        for (int id = c.bid; id < 1024; id += c.G) dn_prep(c, id);
        for (int id = c.bid; id < 1024; id += c.G) ret_kv(c, id);
    }
    if constexpr (K == 3) phase3(c);
    if constexpr (K == 4) {
#ifndef DBG_SKIP_OUT
        { DnPre pre; if (c.bid < 1024) dn_out_load(c, c.bid, pre);
          for (int id = c.bid; id < 1024; id += c.G) dn_out(c, id, (id + c.G < 1024) ? id + c.G : id, pre); }
        for (int id = c.bid; id < 1024; id += c.G) ret_out(c, id);
#endif
    }
    if constexpr (K == 5) {
        {
          float* scr = (float*)(lds + c.wave * 16384); const int gw = c.bid * 8 + c.wave, ngw = c.G * 8;
          constexpr int I_SQ = 16 * 32, I_UP = 16 * (NUP / 32), I_DN = (DFF / 64) * 32;
          for (int it = gw; it < 3 * I_SQ + I_UP + I_DN; it += ngw) {
              if (it < I_SQ) transpose_item<0>(c.w_ret_br, 1024, 1024, (bf16*)(ws + WS_WRET), nullptr, scr, it, 32, c.lane);
              else if (it < 2 * I_SQ) transpose_item<0>(c.w_dn_br, 1024, 1024, (bf16*)(ws + WS_WDN), nullptr, scr, it - I_SQ, 32, c.lane);
              else if (it < 3 * I_SQ) transpose_item<0>(c.w_o, 1024, 1024, (bf16*)(ws + WS_WO), nullptr, scr, it - 2 * I_SQ, 32, c.lane);
              else if (it < 3 * I_SQ + I_UP) transpose_item<2>(c.w_up, 1024, NUP, (bf16*)(ws + WS_WUP), c.g_ffn, scr, it - 3 * I_SQ, NUP / 32, c.lane);
              else transpose_item<0>(c.w_down, DFF, 1024, (bf16*)(ws + WS_WDOWN), nullptr, scr, it - 3 * I_SQ - I_UP, 32, c.lane); }
          __syncthreads(); }
        pg8::Gemm g{(const bf16*)(ws + WS_UX), (const bf16*)(ws + WS_WIN), M, N5, 1024, 1024, 1024}; pg8::StaticOrder S; S.init(M, N5, c.G, c.bid);
        EpiRow8<F5> E{F5{(const float*)(ws + WS_R1), (bf16*)(ws + WS_RV), (bf16*)(ws + WS_DV), (bf16*)(ws + WS_DQ), (bf16*)(ws + WS_DK)}};
        pg8::gemm_phase<EpiRow8<F5>, pg8::StaticOrder, true, true>(ldsl, g, S, E);
    }
    if constexpr (K == 6) {
        static_assert(WS_DV - WS_RV == (size_t)192 * 256 * 1024 * 2 && WS_WDN - WS_WRET == (size_t)4 * 256 * 1024 * 2, "tile offsets of the second GEMM");
        PairOrder S; S.base.init(M, 1024, c.G, c.bid);
        pg8::Gemm g{(const bf16*)(ws + WS_RV), (const bf16*)(ws + WS_WRET), M, 1024, 1024, 1024, 1024};
        Epi6 E{(bf16*)(ws + WS_DQ), (const bf16*)(ws + WS_DK)};
        pg8::gemm_phase<Epi6, PairOrder, true, true>(ldsl, g, S, E);
    }
    if constexpr (K == 7) {
        pg8::Gemm g{(const bf16*)(ws + WS_DQ), (const bf16*)(ws + WS_WO), M, 1024, 1024, 1024, 1024}; pg8::StaticOrder S; S.init(M, 1024, c.G, c.bid);
        EpiRes<true> E{c.x, (bf16*)(ws + WS_H1B), (float*)(ws + WS_SS1)};
        pg8::gemm_phase<EpiRes<true>, pg8::StaticOrder, true, true>(ldsl, g, S, E);
    }
    if constexpr (K == 8) {
        pg8::Gemm g{(const bf16*)(ws + WS_H1B), (const bf16*)(ws + WS_WUP), M, NUP, 1024, 1024, 1024}; pg8::StaticOrder S; S.init(M, NUP, c.G, c.bid);
        Epi8 E{(const float*)(ws + WS_SS1), (bf16*)(ws + WS_ACT), (bf16*)(ws + WS_HBUF), c.ffn_conv_w, c.ffn_conv_b};
        pg8::gemm_phase<Epi8, pg8::StaticOrder, true, true>(ldsl, g, S, E);
#ifdef TIMING_DUP_P8
        __syncthreads();
        pg8::gemm_phase<Epi8, pg8::StaticOrder, true, true>(ldsl, g, S, E);
#endif
    }
    if constexpr (K == 10) {
        pg8::Gemm g{(const bf16*)(ws + WS_ACT), (const bf16*)(ws + WS_WDOWN), M, 1024, DFF, DFF, DFF}; pg8::StaticOrder S; S.init(M, 1024, c.G, c.bid);
        { pg8::Unit u; int last_pm = -1; for (int i = 0; S.next(i, u); ++i) if (u.pm != last_pm) { ffn_fixup(c, u.pm); last_pm = u.pm; }
          asm volatile("s_waitcnt vmcnt(0)" ::: "memory"); __syncthreads(); }
        EpiRes<false> E{nullptr, (bf16*)(ws + WS_H1B), (float*)(ws + WS_SS2)};
        pg8::gemm_phase<EpiRes<false>, pg8::StaticOrder, true, true>(ldsl, g, S, E);
    }
    if constexpr (K == 11) {
        const float* ss2 = (const float*)(ws + WS_SS2);
        for (int row = c.bid * 8 + c.wave; row < M; row += c.G * 8) {
            const float pv = (c.lane < 16) ? ss2[(size_t)row * 16 + c.lane] : 0.f; float s = pv;
#pragma unroll
            for (int o = 1; o < 16; o <<= 1) s += __shfl_xor(s, o);
            s = __shfl(s, 0);
            const float r = rsqrtf(s * (1.f / 1024.f) + EPS);
            f32x4* p = (f32x4*)(c.out + (size_t)row * 1024) + 2 * c.lane; const u32x4* hp = (const u32x4*)((const bf16*)(ws + WS_H1B) + (size_t)row * 1024) + c.lane;
#pragma unroll
            for (int j = 0; j < 2; ++j) { f32x4 a0, a1; unpack8(hp[64 * j], a0, a1);
                const f32x4 g0 = *((const f32x4*)c.g_final + 128 * j + 2 * c.lane), g1 = *((const f32x4*)c.g_final + 128 * j + 2 * c.lane + 1);
                p[128 * j] = a0 * r * g0; p[128 * j + 1] = a1 * r * g1; }
        }
    }

}
struct Args { const float* in[17]; float* out; unsigned char* ws; int ph_lo, ph_hi; };
__global__ void __launch_bounds__(512) fwd_kernel(Args args) {
    extern __shared__ __attribute__((aligned(16))) unsigned char lds[];
    cg::grid_group grid = cg::this_grid();
    Ctx c;
    c.x = args.in[0]; c.g_mix = args.in[1]; c.w_in = args.in[2]; c.ret_norm_g = args.in[3]; c.dn_conv_w = args.in[4]; c.dn_a_log = args.in[5]; c.dn_dt_bias = args.in[6]; c.dn_norm_g = args.in[7];
    c.w_ret_br = args.in[8]; c.w_dn_br = args.in[9]; c.w_o = args.in[10]; c.g_ffn = args.in[11]; c.w_up = args.in[12]; c.ffn_conv_w = args.in[13]; c.ffn_conv_b = args.in[14]; c.w_down = args.in[15]; c.g_final = args.in[16];
    c.out = args.out; c.ws = args.ws; c.lds = lds;
    c.tid = threadIdx.x; c.lane = c.tid & 63; c.wave = __builtin_amdgcn_readfirstlane(c.tid >> 6); c.bid = blockIdx.x; c.G = gridDim.x; c.fr = c.lane & 15; c.fq = c.lane >> 4;
    PG8_LAS unsigned char* ldsl = (PG8_LAS unsigned char*)lds;
    const int lo = args.ph_lo, hi = args.ph_hi;
    unsigned char* ws = args.ws;
    bf16* outb = (bf16*)args.out;
#ifndef PROGRAM_STEPS
#define PROGRAM_STEPS STEP(0, 0) STEP(1, 1) STEP(2, 2) STEP(3, 3) STEP(4, 4) STEP(5, 5) STEP(6, 6) STEP(7, 7) STEP(8, 8) STEP(9, 10) STEP(10, 11)
#endif
    volatile PG8_LAS unsigned* bst = (volatile PG8_LAS unsigned*)(ldsl + LDS_BYTES - 64);
    if (c.tid < 16) bst[c.tid] = 0u;
    __syncthreads();
    XcdBarrier bar = xcd_barrier_post((unsigned*)(ws + WS_CTL), bst);
    if (lo == 0 && hi > 1) grid.sync();
#define STEP(i, k) if (lo <= (i) && (i) < hi) run_phase<k>(c, lds, ldsl, ws, outb); if (lo <= (i) && (i) + 1 < hi) xcd_barrier(bar);
    PROGRAM_STEPS
#undef STEP
#ifdef DBG_DUMP_OFF
    if (lo == 12) {
        const bf16* src = (const bf16*)(ws + (size_t)DBG_DUMP_OFF);
        for (size_t idx = (size_t)c.bid * 512 + c.tid; idx < (size_t)M * 1024; idx += (size_t)c.G * 512) { float v = bf2f(src[idx]); c.out[idx] = (v == v && fabsf(v) < 1e30f) ? v : 12345.f; }
    }
#endif
}

extern "C" void kernel_launch(void* const* d_in, const int* in_sizes, int n_in, void* d_out, int out_size, void* d_ws, size_t ws_size, hipStream_t stream) {
    static int grid = 0;
    if (grid == 0) {
        if (n_in != 17 || out_size != M * D || ws_size < WS_END) { fprintf(stderr, "kernel_launch: unexpected shapes (n_in %d out %d ws %zu)\n", n_in, out_size, ws_size); grid = -1; return; }
        int dev = 0, cus = 0, per_cu = 0;
        if (hipGetDevice(&dev) != hipSuccess || hipDeviceGetAttribute(&cus, hipDeviceAttributeMultiprocessorCount, dev) != hipSuccess) { grid = -1; return; }
        if (hipFuncSetAttribute((const void*)fwd_kernel, hipFuncAttributeMaxDynamicSharedMemorySize, LDS_BYTES) != hipSuccess) { fprintf(stderr, "kernel_launch: hipFuncSetAttribute failed\n"); grid = -1; return; }
        if (hipOccupancyMaxActiveBlocksPerMultiprocessor(&per_cu, (const void*)fwd_kernel, 512, LDS_BYTES) != hipSuccess || per_cu < 1) { fprintf(stderr, "kernel_launch: occupancy query says %d\n", per_cu); per_cu = 1; }
        (void)hipGetLastError();
        grid = cus;
    }
    if (grid < 0) return;
    Args a{};
    for (int i = 0; i < 17; ++i) a.in[i] = (const float*)d_in[i];
    a.out = (float*)d_out; a.ws = (unsigned char*)d_ws;
#if N_LAUNCH_MODE == 1
    if (hipMemsetAsync((char*)d_ws + WS_CTL, 0, CTL_BYTES, stream) != hipSuccess) { fprintf(stderr, "kernel_launch: memset of the barrier words failed\n"); return; }
    a.ph_lo = 0; a.ph_hi = NPHASE;
    void* kargs[] = {&a};
    hipError_t e = hipLaunchCooperativeKernel((const void*)fwd_kernel, dim3(grid), dim3(512), kargs, LDS_BYTES, stream);
    if (e != hipSuccess) fprintf(stderr, "kernel_launch: cooperative launch failed: %s (grid %d)\n", hipGetErrorString(e), grid);
#else
    for (int ph = 0; ph < NPHASE; ++ph) { a.ph_lo = ph; a.ph_hi = ph + 1; hipLaunchKernelGGL(fwd_kernel, dim3(grid), dim3(512), LDS_BYTES, stream, a); }
#ifdef DBG_DUMP_OFF
    a.ph_lo = 12; a.ph_hi = 13; hipLaunchKernelGGL(fwd_kernel, dim3(grid), dim3(512), LDS_BYTES, stream, a);
#endif
#endif
}
```

```cpp
#include <hip/hip_runtime.h>
#include <hip/hip_cooperative_groups.h>
#include <cstdio>
#include <cstdint>
namespace cg = cooperative_groups;
namespace pg8 {
#define PG8_LAS __attribute__((address_space(3)))
typedef unsigned short bf16_t;
typedef short bf16x8 __attribute__((ext_vector_type(8)));
typedef float f32x4 __attribute__((ext_vector_type(4)));
typedef unsigned u32x4 __attribute__((ext_vector_type(4)));
constexpr int BM = 256, BK = 64, HALF = 128, HTB = HALF * BK * 2  , STAGE_BYTES = 8 * HTB, NXCD = 8, WGM = 4;

__host__ __device__ __forceinline__ int lds_byte(int r, int c) { const int st = (r >> 4) * 2 + (c >> 5), rr = r & 15, cc = c & 31, ob = rr * 64 + cc * 2; return st * 1024 + (ob ^ (((ob >> 9) & 1) << 5)); }
__host__ __device__ __forceinline__ void stage_rc(int b, int& R, int& C) { const int st = b / 1024, sb = b % 1024, swz = sb ^ (((sb >> 9) & 1) << 5); R = (st >> 1) * 16 + swz / 64; C = (st & 1) * 32 + (swz % 64) / 2; }
__host__ __device__ __forceinline__ int perm32(int rho) { const int n = rho >> 4, i = rho & 15; return 8 * (i >> 2) + 4 * n + (i & 3); }

struct Unit { int pm, pn; };
struct Gemm { const bf16_t* A; const bf16_t* Bt; int M, N, K, lda, ldb; };

struct StaticOrder {
    int nM, nN, nwg, G, c;
    __host__ __device__ void init(int M, int N, int G_, int c_) { nM = M / BM; nN = N / BM; nwg = nM * nN; G = G_; c = c_; }
    __host__ __device__ bool next(int i, Unit& u) const {
        const long L = (long)i * G + c; if (L >= nwg) return false;
        int wgid = (int)L; { const int q = nwg / NXCD, r = nwg % NXCD, xcd = wgid % NXCD, off = wgid / NXCD; wgid = (xcd < r ? xcd * (q + 1) : r * (q + 1) + (xcd - r) * q) + off; }
        const int nig = WGM * nN, gid = wgid / nig, fm = gid * WGM, gsz = (nM - fm) < WGM ? (nM - fm) : WGM;
        u.pm = fm + ((wgid % nig) % gsz); u.pn = (wgid % nig) / gsz; return true;
    }
    __device__ __forceinline__ void a_ready(const Unit&) const {}
    __device__ __forceinline__ void done(const Unit&) const {}
};

__device__ __forceinline__ unsigned cvt_pk_bf16(float lo, float hi) { unsigned r; asm volatile("v_cvt_pk_bf16_f32 %0, %1, %2" : "=v"(r) : "v"(lo), "v"(hi)); return r; }
template <class Epi, class Sched, bool ALIGN_EPI = false, bool SP2 = false>
__device__ __forceinline__ void gemm_phase(PG8_LAS unsigned char* lds, const Gemm g, const Sched& S, const Epi& E) {
    const int tid = threadIdx.x, wid = __builtin_amdgcn_readfirstlane(tid >> 6), lane = tid & 63, wr = wid >> 2, wc = wid & 3, fr = lane & 15, fq = lane >> 4;
    const int K = g.K, nt = K / BK;
    unsigned voffA[2], voffB[2];
#pragma unroll
    for (int i = 0; i < 2; ++i) { int R, C; stage_rc(tid * 16 + i * 8192, R, C); const int Rb = Epi::PERM ? ((R & ~31) + perm32(R & 31)) : R;
        voffA[i] = (unsigned)(R * g.lda + C) * 2u; voffB[i] = (unsigned)(Rb * g.ldb + C) * 2u; }
    const size_t kstep = (size_t)(BK * 2);
    const size_t hstepA = (size_t)HALF * g.lda * 2, hstepB = (size_t)HALF * g.ldb * 2;
    const size_t tstepA = 2 * hstepA, tstepB = 2 * hstepB;
    const unsigned ldsw = (unsigned)wid * 1024u;
    const int aoff = lds_byte(wr * 64 + fr, fq * 8), boff = lds_byte(wc * 32 + fr, fq * 8);
#define PG8_SA(b, h) (((b) * 2 + (h)) * HTB)
#define PG8_SB(b, h) ((4 + (b) * 2 + (h)) * HTB)
#define PG8_STAGE(bufoff, gbase, voff) do { _Pragma("unroll") for (int _i = 0; _i < 2; ++_i) \
        __builtin_amdgcn_global_load_lds((const unsigned*)((const char*)(gbase) + (voff)[_i]), (PG8_LAS unsigned*)(lds + (bufoff) + ldsw + _i * 8192), 16, 0, 0); } while (0)
#define PG8_LDA(dst, b, h) do { _Pragma("unroll") for (int m = 0; m < 4; ++m) _Pragma("unroll") for (int k = 0; k < 2; ++k) dst[m][k] = *(const PG8_LAS bf16x8*)(lds + PG8_SA(b, h) + aoff + m * 2048 + k * 1024); } while (0)
#define PG8_LDB(dst, b, h) do { _Pragma("unroll") for (int n = 0; n < 2; ++n) _Pragma("unroll") for (int k = 0; k < 2; ++k) dst[n][k] = *(const PG8_LAS bf16x8*)(lds + PG8_SB(b, h) + boff + n * 2048 + k * 1024); } while (0)
#define PG8_MMA(ai, bj, At, Bt) do { __builtin_amdgcn_s_setprio(1); _Pragma("unroll") for (int m = 0; m < 4; ++m) _Pragma("unroll") for (int n = 0; n < 2; ++n) _Pragma("unroll") for (int k = 0; k < 2; ++k) \
        acc[ai][bj][m][n] = __builtin_amdgcn_mfma_f32_16x16x32_bf16(Bt[n][k], At[m][k], acc[ai][bj][m][n], 0, 0, 0); __builtin_amdgcn_s_setprio(0); } while (0)
#define PG8_WAIT_V(n) asm volatile("s_waitcnt vmcnt(" #n ")" ::: "memory")
#define PG8_WAIT_L(n) asm volatile("s_waitcnt lgkmcnt(" #n ")" ::: "memory")
#define PG8_BAR __builtin_amdgcn_s_barrier()
#define PG8_SCHED __builtin_amdgcn_sched_barrier(0)
    Unit cur, nxt; int ui = 0;
    if (!S.next(0, cur)) return;
    f32x4 acc[2][2][4][2];
#pragma unroll
    for (int a = 0; a < 2; ++a)
#pragma unroll
        for (int b = 0; b < 2; ++b)
#pragma unroll
            for (int m = 0; m < 4; ++m)
#pragma unroll
                for (int n = 0; n < 2; ++n) acc[a][b][m][n] = (f32x4){0.f, 0.f, 0.f, 0.f};
    bf16x8 At[4][2], B0[2][2], B1[2][2];
    const char* cA = (const char*)g.A + (size_t)cur.pm * tstepA; const char* cB = (const char*)g.Bt + (size_t)cur.pn * tstepB;
    S.a_ready(cur);
    if constexpr (SP2) {
        PG8_STAGE(PG8_SB(0, 0), cB, voffB); PG8_STAGE(PG8_SB(0, 1), cB + hstepB, voffB); PG8_STAGE(PG8_SA(0, 0), cA, voffA); PG8_STAGE(PG8_SA(0, 1), cA + hstepA, voffA);
        if (wr == 1) PG8_BAR;
        PG8_WAIT_V(2); PG8_BAR;
        PG8_STAGE(PG8_SB(1, 0), cB + kstep, voffB); PG8_STAGE(PG8_SA(1, 0), cA + kstep, voffA); PG8_STAGE(PG8_SB(1, 1), cB + hstepB + kstep, voffB);
        PG8_WAIT_V(6); PG8_BAR;
    } else {
        PG8_STAGE(PG8_SB(0, 0), cB, voffB); PG8_STAGE(PG8_SA(0, 0), cA, voffA); PG8_STAGE(PG8_SB(0, 1), cB + hstepB, voffB); PG8_STAGE(PG8_SA(0, 1), cA + hstepA, voffA);
        if (wr == 1) PG8_BAR;
        PG8_WAIT_V(4); PG8_BAR;
        PG8_STAGE(PG8_SB(1, 0), cB + kstep, voffB); PG8_STAGE(PG8_SA(1, 0), cA + kstep, voffA); PG8_STAGE(PG8_SB(1, 1), cB + hstepB + kstep, voffB);
        PG8_WAIT_V(6); PG8_BAR;
    }
    for (;;) {
        const bool has_next = S.next(ui + 1, nxt);
        const char* nA = has_next ? (const char*)g.A + (size_t)nxt.pm * tstepA : cA; const char* nB = has_next ? (const char*)g.Bt + (size_t)nxt.pn * tstepB : cB;
        for (int t = 0; t < nt; t += 2) {
            const bool last = (t == nt - 2);
            const char* a1 = cA + (size_t)(t + 1) * kstep;
            const char* a2 = last ? nA : cA + (size_t)(t + 2) * kstep; const char* b2 = last ? nB : cB + (size_t)(t + 2) * kstep;
            const char* a3 = a2 + kstep; const char* b3 = b2 + kstep;
            if (last && has_next) S.a_ready(nxt);
            if constexpr (SP2) {
            PG8_LDB(B0, 0, 0); PG8_LDB(B1, 0, 1); PG8_SCHED; PG8_LDA(At, 0, 0); PG8_STAGE(PG8_SA(1, 1), a1 + hstepA, voffA);
            PG8_WAIT_V(8); PG8_WAIT_L(0); PG8_BAR; PG8_MMA(0, 0, At, B0); PG8_MMA(0, 1, At, B1); PG8_BAR; PG8_SCHED;
            PG8_LDA(At, 0, 1); PG8_STAGE(PG8_SB(0, 0), b2, voffB); PG8_STAGE(PG8_SB(0, 1), b2 + hstepB, voffB); PG8_STAGE(PG8_SA(0, 0), a2, voffA);
            PG8_WAIT_V(8); PG8_WAIT_L(0); PG8_BAR; PG8_MMA(1, 0, At, B0); PG8_MMA(1, 1, At, B1); PG8_BAR; PG8_SCHED;
            PG8_LDB(B0, 1, 0); PG8_LDB(B1, 1, 1); PG8_SCHED; PG8_LDA(At, 1, 0); PG8_STAGE(PG8_SA(0, 1), a2 + hstepA, voffA);
            PG8_WAIT_V(8); PG8_WAIT_L(0); PG8_BAR; PG8_MMA(0, 0, At, B0); PG8_MMA(0, 1, At, B1); PG8_BAR; PG8_SCHED;
            PG8_LDA(At, 1, 1); PG8_STAGE(PG8_SB(1, 0), b3, voffB); PG8_STAGE(PG8_SB(1, 1), b3 + hstepB, voffB); PG8_STAGE(PG8_SA(1, 0), a3, voffA);
            PG8_WAIT_V(8); PG8_WAIT_L(0); PG8_BAR; PG8_MMA(1, 0, At, B0); PG8_MMA(1, 1, At, B1); PG8_BAR; PG8_SCHED;
            } else {
            PG8_LDB(B0, 0, 0); PG8_SCHED; PG8_LDA(At, 0, 0); PG8_STAGE(PG8_SA(1, 1), a1 + hstepA, voffA);
            PG8_WAIT_L(8); PG8_BAR; PG8_WAIT_L(0); PG8_MMA(0, 0, At, B0); PG8_BAR; PG8_SCHED;
            PG8_LDB(B1, 0, 1); PG8_STAGE(PG8_SB(0, 0), b2, voffB);
            PG8_BAR; PG8_WAIT_L(0); PG8_MMA(0, 1, At, B1); PG8_BAR;
            PG8_LDA(At, 0, 1); PG8_STAGE(PG8_SA(0, 0), a2, voffA);
            PG8_BAR; PG8_WAIT_L(0); PG8_MMA(1, 0, At, B0); PG8_BAR; PG8_SCHED;
            PG8_STAGE(PG8_SB(0, 1), b2 + hstepB, voffB);
            PG8_WAIT_V(6); PG8_BAR; PG8_MMA(1, 1, At, B1); PG8_BAR;
            PG8_LDB(B0, 1, 0); PG8_SCHED; PG8_LDA(At, 1, 0); PG8_STAGE(PG8_SA(0, 1), a2 + hstepA, voffA);
            PG8_WAIT_L(8); PG8_BAR; PG8_WAIT_L(0); PG8_MMA(0, 0, At, B0); PG8_BAR; PG8_SCHED;
            PG8_LDB(B1, 1, 1); PG8_STAGE(PG8_SB(1, 0), b3, voffB);
            PG8_BAR; PG8_WAIT_L(0); PG8_MMA(0, 1, At, B1); PG8_BAR;
            PG8_LDA(At, 1, 1); PG8_STAGE(PG8_SA(1, 0), a3, voffA);
            PG8_BAR; PG8_WAIT_L(0); PG8_MMA(1, 0, At, B0); PG8_BAR; PG8_SCHED;
            PG8_STAGE(PG8_SB(1, 1), b3 + hstepB, voffB);
            PG8_WAIT_V(6); PG8_BAR; PG8_MMA(1, 1, At, B1); PG8_BAR;
            }
        }
        if constexpr (ALIGN_EPI) { if (wr == 0) PG8_BAR; }
        if constexpr (!Epi::AFTER_DRAIN) { E(acc, cur, wr, wc, fr, fq); S.done(cur); }
        if (!has_next) break;
#pragma unroll
        for (int a = 0; a < 2; ++a)
#pragma unroll
            for (int b = 0; b < 2; ++b)
#pragma unroll
                for (int m = 0; m < 4; ++m)
#pragma unroll
                    for (int n = 0; n < 2; ++n) acc[a][b][m][n] = (f32x4){0.f, 0.f, 0.f, 0.f};
        cur = nxt; cA = nA; cB = nB; ++ui;
        if constexpr (ALIGN_EPI) { if (wr == 1) PG8_BAR; }
    }
    PG8_WAIT_V(0);
    if constexpr (!ALIGN_EPI) { if (wr == 0) PG8_BAR; }
    PG8_BAR;
    if constexpr (Epi::AFTER_DRAIN) { E.fused(acc, cur, wr, wc, fr, fq, lds, wid, lane); S.done(cur); }
#undef PG8_SA
#undef PG8_SB
#undef PG8_STAGE
#undef PG8_LDA
#undef PG8_LDB
#undef PG8_MMA
#undef PG8_WAIT_V
#undef PG8_WAIT_L
#undef PG8_BAR
#undef PG8_SCHED
}
}
#define DBG_SOLVE 0
#define NPHASE_STEPS 11
#define PROGRAM_STEPS STEP(0, 0) STEP(1, 1) STEP(2, 2) STEP(3, 3) STEP(4, 4) STEP(5, 5) STEP(6, 6) STEP(7, 7) STEP(8, 8) STEP(9, 10) STEP(10, 11)
typedef unsigned short bf16;
typedef short bf16x8 __attribute__((ext_vector_type(8)));
typedef short bf16x4 __attribute__((ext_vector_type(4)));
typedef float f32x4 __attribute__((ext_vector_type(4)));
typedef float f32x2 __attribute__((ext_vector_type(2)));
typedef unsigned u32x4 __attribute__((ext_vector_type(4)));
typedef unsigned u32x2 __attribute__((ext_vector_type(2)));

constexpr int NB = 4, T = 4096, D = 1024, M = NB * T, H = 8, CH = 128, NCH = T / CH;
constexpr int DFF = 2816, NUP = 2 * DFF;
constexpr int N1 = 5120, N5 = 4096, NIN = 9216, DIN = 9232;
constexpr float EPS = 1e-6f, GN_EPS = 1e-5f;
constexpr size_t MiB = 1u << 20;
constexpr size_t WS_CTL = 0, CTL_BYTES = 16384;
constexpr size_t WS_R1 = MiB / 4, WS_GB = MiB / 2, WS_SS1 = 3 * MiB / 2, WS_SS2 = 5 * MiB / 2, WS_ROPE = 7 * MiB / 2, WS_GC = 9 * MiB / 2, WS_HALO = 5 * MiB;
constexpr size_t WS_WIN = 8 * MiB;
constexpr size_t WS_KV = 16 * MiB, WS_UX = 32 * MiB, WS_H1B = 32 * MiB;
constexpr size_t WS_RQ = 64 * MiB, WS_RK = 80 * MiB, WS_RV = 96 * MiB, WS_DQ = 128 * MiB, WS_DK = 160 * MiB, WS_DV = 192 * MiB;
constexpr size_t WS_SN = 224 * MiB;
constexpr size_t WS_WRET = 224 * MiB, WS_WDN = 226 * MiB, WS_WO = 228 * MiB, WS_WUP = 230 * MiB, WS_WDOWN = 241 * MiB;
constexpr size_t WS_ACT = 64 * MiB, WS_HBUF = 152 * MiB, WS_END = 256 * MiB;
constexpr size_t OUT_W = 0, OUT_KDT = 32 * MiB;
constexpr int LDS_BYTES = 147456;
#ifndef NPHASE_STEPS
#define NPHASE_STEPS 11
#endif
constexpr int NPHASE = NPHASE_STEPS;

#ifndef N_LAUNCH_MODE
#define N_LAUNCH_MODE 1
#endif

typedef __bf16 bf16x2n __attribute__((ext_vector_type(2)));
__device__ __forceinline__ unsigned pk2(float lo, float hi) { const f32x2 f = {lo, hi}; return __builtin_bit_cast(unsigned, __builtin_convertvector(f, bf16x2n)); }
__device__ __forceinline__ float bflo(unsigned u) { return __uint_as_float(u << 16); }
__device__ __forceinline__ float bfhi(unsigned u) { return __uint_as_float(u & 0xffff0000u); }
__device__ __forceinline__ float bf2f(bf16 h) { return __uint_as_float(((unsigned)h) << 16); }
__device__ __forceinline__ bf16 f2bf(float f) { return (bf16)(pk2(f, 0.f) & 0xffffu); }
__device__ __forceinline__ float silu_f(float x) { return x * __builtin_amdgcn_rcpf(1.f + __expf(-x)); }
__device__ __forceinline__ float sigm_f(float x) { return __builtin_amdgcn_rcpf(1.f + __expf(-x)); }
__device__ __forceinline__ f32x4 mfma32(bf16x8 a, bf16x8 b, f32x4 c) { return __builtin_amdgcn_mfma_f32_16x16x32_bf16(a, b, c, 0, 0, 0); }
__device__ __forceinline__ f32x4 mfma16(bf16x4 a, bf16x4 b, f32x4 c) { return __builtin_amdgcn_mfma_f32_16x16x16bf16_1k(a, b, c, 0, 0, 0); }
__device__ __forceinline__ bf16x4 pack4(f32x4 v) { u32x2 w; w.x = pk2(v[0], v[1]); w.y = pk2(v[2], v[3]); return __builtin_bit_cast(bf16x4, w); }
__device__ __forceinline__ u32x4 pack8(f32x4 a, f32x4 b) { u32x4 w; w.x = pk2(a[0], a[1]); w.y = pk2(a[2], a[3]); w.z = pk2(b[0], b[1]); w.w = pk2(b[2], b[3]); return w; }
__device__ __forceinline__ void unpack8(u32x4 w, f32x4& a, f32x4& b) { a = (f32x4){bflo(w.x), bfhi(w.x), bflo(w.y), bfhi(w.y)}; b = (f32x4){bflo(w.z), bfhi(w.z), bflo(w.w), bfhi(w.w)}; }
#define LDSWAIT() asm volatile("s_waitcnt lgkmcnt(0)" ::: "memory")

struct Ctx {
    const float *x, *g_mix, *w_in, *ret_norm_g, *dn_conv_w, *dn_a_log, *dn_dt_bias, *dn_norm_g, *w_ret_br, *w_dn_br, *w_o, *g_ffn, *w_up, *ffn_conv_w, *ffn_conv_b, *w_down, *g_final;
    float* out; unsigned char* ws; unsigned char* lds;
    int tid, lane, wave, bid, G, fr, fq;
};

template <class F> struct EpiRow8 {
    static constexpr bool PERM = true, AFTER_DRAIN = false; F f;
    __device__ __forceinline__ void operator()(const pg8::f32x4 (&acc)[2][2][4][2], const pg8::Unit& u, int wr, int wc, int fr, int fq) const {
#pragma unroll
        for (int ai = 0; ai < 2; ++ai)
#pragma unroll
            for (int m = 0; m < 4; ++m) { const int row = u.pm * 256 + ai * 128 + wr * 64 + m * 16 + fr;
#pragma unroll
                for (int bj = 0; bj < 2; ++bj) { const int col = u.pn * 256 + bj * 128 + wc * 32 + 8 * fq; f(row, col, acc[ai][bj][m][0], acc[ai][bj][m][1]); } }
    }
};

struct F1 {
    const float* r1; const float* rope; bf16 *rq, *rk, *rv, *dqkv, *halo;
    __device__ __forceinline__ void operator()(int row, int col, f32x4 v0, f32x4 v1) const {
        const float r = r1[row]; v0 = v0 * r; v1 = v1 * r;
        if (col < 1024) {
            const int t = row & (T - 1), p0 = (col & 63) >> 1;
            const f32x4 cs0 = *(const f32x4*)(rope + ((size_t)t * 32 + p0) * 2), cs1 = *(const f32x4*)(rope + ((size_t)t * 32 + p0) * 2 + 4);
            const float sc = col >= 512 ? 0.125f : 1.f;
            f32x4 o0, o1;
            o0[0] = (v0[0] * cs0[0] - v0[1] * cs0[1]) * sc; o0[1] = (v0[0] * cs0[1] + v0[1] * cs0[0]) * sc;
            o0[2] = (v0[2] * cs0[2] - v0[3] * cs0[3]) * sc; o0[3] = (v0[2] * cs0[3] + v0[3] * cs0[2]) * sc;
            o1[0] = (v1[0] * cs1[0] - v1[1] * cs1[1]) * sc; o1[1] = (v1[0] * cs1[1] + v1[1] * cs1[0]) * sc;
            o1[2] = (v1[2] * cs1[2] - v1[3] * cs1[3]) * sc; o1[3] = (v1[2] * cs1[3] + v1[3] * cs1[2]) * sc;
            bf16* dst = (col < 512 ? rq : rk) + (size_t)row * 512 + (col & 511);
            *(u32x4*)dst = pack8(o0, o1);
        } else if (col < 2048) {
            *(u32x4*)(rv + (size_t)row * 1024 + (col - 1024)) = pack8(v0, v1);
        } else {
            const int cc = col - 2048; const u32x4 w = pack8(v0, v1);
            *(u32x4*)(dqkv + (size_t)(cc >> 10) * ((size_t)M * 1024) + (size_t)row * 1024 + (cc & 1023)) = w;
            if ((row & 127) >= 125) *(u32x4*)(halo + ((size_t)(row >> 7) * 3 + ((row & 127) - 125)) * 3072 + cc) = w;
        }
    }
};
struct F5 {
    const float* r1; bf16 *rv, *dv, *sigr, *sigd;
    __device__ __forceinline__ void operator()(int row, int col, f32x4 v0, f32x4 v1) const {
        const float r = r1[row]; v0 = v0 * r; v1 = v1 * r;
        const int t = col >> 10, cc = col & 1023;
        if (t < 2) {
            bf16* p = (t == 0 ? rv : dv) + (size_t)row * 1024 + cc; f32x4 a, b; unpack8(*(const u32x4*)p, a, b);
#pragma unroll
            for (int e = 0; e < 4; ++e) { a[e] *= silu_f(v0[e]); b[e] *= silu_f(v1[e]); }
            *(u32x4*)p = pack8(a, b);
        } else {
            bf16* p = (t == 2 ? sigr : sigd) + (size_t)row * 1024 + cc; f32x4 a, b;
#pragma unroll
            for (int e = 0; e < 4; ++e) { a[e] = sigm_f(v0[e]); b[e] = sigm_f(v1[e]); }
            *(u32x4*)p = pack8(a, b);
        }
    }
};
struct F6a { bf16* sigr;
    __device__ __forceinline__ void operator()(int row, int col, f32x4 v0, f32x4 v1) const {
        bf16* p = sigr + (size_t)row * 1024 + col; f32x4 a, b; unpack8(*(const u32x4*)p, a, b); a = a * v0; b = b * v1; *(u32x4*)p = pack8(a, b); }
};
struct F6b { bf16* sigr; const bf16* sigd;
    __device__ __forceinline__ void operator()(int row, int col, f32x4 v0, f32x4 v1) const {
        bf16* p = sigr + (size_t)row * 1024 + col; f32x4 a, b, s0, s1; unpack8(*(const u32x4*)p, a, b); unpack8(*(const u32x4*)(sigd + (size_t)row * 1024 + col), s0, s1);
        a = a + s0 * v0; b = b + s1 * v1; *(u32x4*)p = pack8(a, b); }
};
template <bool BASE_F32> struct EpiRes {
    static constexpr bool PERM = true, AFTER_DRAIN = false;
    const float* basef; bf16* hb; float* ss;
    __device__ __forceinline__ void operator()(const pg8::f32x4 (&acc)[2][2][4][2], const pg8::Unit& u, int wr, int wc, int fr, int fq) const {
#pragma unroll
        for (int ai = 0; ai < 2; ++ai)
#pragma unroll
            for (int m = 0; m < 4; ++m) { const int row = u.pm * 256 + ai * 128 + wr * 64 + m * 16 + fr; float ssq = 0.f;
#pragma unroll
                for (int bj = 0; bj < 2; ++bj) { const int col = u.pn * 256 + bj * 128 + wc * 32 + 8 * fq; const size_t off = (size_t)row * 1024 + col;
                    f32x4 b0, b1;
                    if (BASE_F32) { b0 = *(const f32x4*)(basef + off); b1 = *(const f32x4*)(basef + off + 4); } else unpack8(*(const u32x4*)(hb + off), b0, b1);
                    const f32x4 h0 = b0 + acc[ai][bj][m][0], h1 = b1 + acc[ai][bj][m][1];
                    *(u32x4*)(hb + off) = pack8(h0, h1);
                    ssq += (h0[0] * h0[0] + h0[1] * h0[1]) + (h0[2] * h0[2] + h0[3] * h0[3]) + (h1[0] * h1[0] + h1[1] * h1[1]) + (h1[2] * h1[2] + h1[3] * h1[3]); }
                ssq += __shfl_xor(ssq, 16); ssq += __shfl_xor(ssq, 32);
                if (fq == 0) ss[(size_t)row * 16 + u.pn * 4 + wc] = ssq; }
    }
};
__device__ __forceinline__ float dpp_ror1(float v) { return __builtin_bit_cast(float, __builtin_amdgcn_mov_dpp(__builtin_bit_cast(int, v), 0x121, 0xf, 0xf, false)); }
__device__ __forceinline__ float dpp_ror2(float v) { return __builtin_bit_cast(float, __builtin_amdgcn_mov_dpp(__builtin_bit_cast(int, v), 0x122, 0xf, 0xf, false)); }
struct Epi8 {
    static constexpr bool PERM = true, AFTER_DRAIN = false;
    const float* ss; bf16 *act, *hbuf; const float *cw, *cb;
    __device__ __forceinline__ void operator()(const pg8::f32x4 (&acc)[2][2][4][2], const pg8::Unit& u, int wr, int wc, int fr, int fq) const {
#pragma unroll
        for (int bj = 0; bj < 2; ++bj) {
            const int col = u.pn * 256 + bj * 128 + wc * 32 + 8 * fq, j0 = col >> 1;
            f32x4 W0[3], W1[3], B0, B1;
            { f32x4 wa[3], wb[3];
#pragma unroll
              for (int k = 0; k < 3; ++k) { wa[k] = *(const f32x4*)(cw + (size_t)k * NUP + j0); wb[k] = *(const f32x4*)(cw + (size_t)k * NUP + DFF + j0);
                  W0[k] = (f32x4){wa[k][0], wb[k][0], wa[k][1], wb[k][1]}; W1[k] = (f32x4){wa[k][2], wb[k][2], wa[k][3], wb[k][3]}; }
              const f32x4 ba = *(const f32x4*)(cb + j0), bb = *(const f32x4*)(cb + DFF + j0);
              B0 = (f32x4){ba[0], bb[0], ba[1], bb[1]}; B1 = (f32x4){ba[2], bb[2], ba[3], bb[3]}; }
#pragma unroll
            for (int ai = 0; ai < 2; ++ai) {
                f32x4 pv0 = (f32x4){0.f, 0.f, 0.f, 0.f}, pv1 = pv0;
#pragma unroll
                for (int m = 0; m < 4; ++m) {
                    const int row = u.pm * 256 + ai * 128 + wr * 64 + m * 16 + fr;
                    const f32x4* sp = (const f32x4*)(ss + (size_t)row * 16); const f32x4 s4 = (sp[0] + sp[1]) + (sp[2] + sp[3]);
                    const float rr = rsqrtf(((s4[0] + s4[1]) + (s4[2] + s4[3])) * (1.f / 1024.f) + EPS);
                    const f32x4 c0 = acc[ai][bj][m][0] * rr, c1 = acc[ai][bj][m][1] * rr;
                    f32x4 p10, p11, p20, p21;
#pragma unroll
                    for (int e = 0; e < 4; ++e) {
                        p10[e] = dpp_ror1(fr == 15 ? pv0[e] : c0[e]); p11[e] = dpp_ror1(fr == 15 ? pv1[e] : c1[e]);
                        p20[e] = dpp_ror2(fr >= 14 ? pv0[e] : c0[e]); p21[e] = dpp_ror2(fr >= 14 ? pv1[e] : c1[e]); }
                    const f32x4 y0 = W0[0] * p20 + W0[1] * p10 + W0[2] * c0 + B0, y1 = W1[0] * p21 + W1[1] * p11 + W1[2] * c1 + B1;
                    const f32x4 o = (f32x4){silu_f(y0[0]) * y0[1], silu_f(y0[2]) * y0[3], silu_f(y1[0]) * y1[1], silu_f(y1[2]) * y1[3]};
                    const bool head = (m == 0) && (fr < 2);
                    if (!head) *(bf16x4*)(act + (size_t)row * DFF + j0) = pack4(o);
                    if (head || (m == 3 && fr >= 14)) { const int slot = (m == 0) ? fr : (fr - 12);
                        *(u32x4*)(hbuf + ((size_t)(row >> 6) * 4 + slot) * NUP + col) = pack8(c0, c1); }
                    pv0 = c0; pv1 = c1;
                    asm volatile("" ::: "memory");
                }
            }
        }
    }
};

__device__ __forceinline__ int win_srccol_old(int n) {
    if (n < 1024) return (n & ~63) + ((n & 63) >> 1) + 32 * (n & 1);
    if (n < 2048) return n;
    if (n < 5120) return n + 1024;
    if (n < 6144) return n - 5120 + 2048;
    if (n < 7168) return n;
    return n + 16;
}
__device__ __forceinline__ int win_srccol(int n) { return win_srccol_old(n < N5 ? n + N1 : n - N5); }
template <int MAP> __device__ __forceinline__ void transpose_item(const float* W, int K, int N, bf16* WT, const float* gk, float* scr, int item, int nblk, int lane) {
    const int kb = item / nblk, nb = item % nblk, k0 = 64 * kb, n0 = 32 * nb;
    const int nsrc = MAP == 1 ? win_srccol(n0 + (lane & 31)) : (MAP == 2 ? (((n0 + (lane & 31)) >> 1) + DFF * ((n0 + (lane & 31)) & 1)) : (n0 + (lane & 31)));
#pragma unroll 8
    for (int i = 0; i < 32; ++i) { const int kk = 2 * i + (lane >> 5); float v = W[(size_t)(k0 + kk) * N + nsrc]; if (gk) v *= gk[k0 + kk]; scr[kk * 33 + (lane & 31)] = v; }
    LDSWAIT();
    const int c = lane & 7;
#pragma unroll
    for (int j = 0; j < 4; ++j) { const int n = (lane >> 3) + 8 * j; const float* s = scr + (8 * c) * 33 + n;
        u32x4 o; o.x = pk2(s[0 * 33], s[1 * 33]); o.y = pk2(s[2 * 33], s[3 * 33]); o.z = pk2(s[4 * 33], s[5 * 33]); o.w = pk2(s[6 * 33], s[7 * 33]);
        *(u32x4*)(WT + (size_t)(n0 + n) * K + k0 + 8 * c) = o; }
    LDSWAIT();
}
__device__ __forceinline__ void phase0(const Ctx& c) {
    float* scr = (float*)(c.lds + c.wave * 16384);
    const int gw = c.bid * 8 + c.wave, ngw = c.G * 8;
    constexpr int I_IN = 16 * (NIN / 32);
    for (int it = gw; it < I_IN; it += ngw) transpose_item<1>(c.w_in, 1024, DIN, (bf16*)(c.ws + WS_WIN), nullptr, scr, it, NIN / 32, c.lane);
    float* rope = (float*)(c.ws + WS_ROPE);
    for (int i = c.bid * 512 + c.tid; i < T * 32; i += c.G * 512) { const int t = i >> 5, p = i & 31;
        const float inv = exp2f(-(float)p * 0.41524101186092029f); const float ang = (float)t * inv;
        const double rev = (double)ang * 0.15915494309189535; const float fr_ = (float)(rev - rint(rev));
        rope[2 * i] = __cosf(fr_ * 6.283185307179586f); rope[2 * i + 1] = __sinf(fr_ * 6.283185307179586f); }
    __syncthreads();
    bf16* wab = (bf16*)c.lds;
    for (int i = c.tid; i < 16 * 1024; i += 512) { const int n = i & 15, k = i >> 4; wab[n * 1032 + k] = f2bf(c.w_in[(size_t)k * DIN + 7168 + n]); }
    __syncthreads();
    bf16* Ux = (bf16*)(c.ws + WS_UX); float* r1 = (float*)(c.ws + WS_R1); float* gb = (float*)(c.ws + WS_GB);
    const int fr = c.fr, fq = c.fq;
    if ((c.wave & 1) == 0) for (int gi = c.bid * 4 + (c.wave >> 1); gi < M / 16; gi += c.G * 4) {
        const int row0 = gi * 16; const float* xr = c.x + (size_t)(row0 + fr) * 1024 + 8 * fq; bf16* ur = Ux + (size_t)(row0 + fr) * 1024 + 8 * fq;
        f32x4 acc = (f32x4){0.f, 0.f, 0.f, 0.f}; float ssq = 0.f;
#pragma unroll 4
        for (int kk = 0; kk < 32; ++kk) {
            f32x4 a0 = *(const f32x4*)(xr + 32 * kk), a1 = *(const f32x4*)(xr + 32 * kk + 4);
            const f32x4 g0 = *(const f32x4*)(c.g_mix + 32 * kk + 8 * fq), g1 = *(const f32x4*)(c.g_mix + 32 * kk + 8 * fq + 4);
            ssq += (a0[0] * a0[0] + a0[1] * a0[1]) + (a0[2] * a0[2] + a0[3] * a0[3]) + (a1[0] * a1[0] + a1[1] * a1[1]) + (a1[2] * a1[2] + a1[3] * a1[3]);
            a0 = a0 * g0; a1 = a1 * g1; const u32x4 pk = pack8(a0, a1);
            *(u32x4*)(ur + 32 * kk) = pk;
            const bf16x8 bfr = *(const bf16x8*)(wab + fr * 1032 + 32 * kk + 8 * fq);
            acc = mfma32(__builtin_bit_cast(bf16x8, pk), bfr, acc);
        }
        ssq += __shfl_xor(ssq, 16); ssq += __shfl_xor(ssq, 32);
        const float r = rsqrtf(ssq * (1.f / 1024.f) + EPS);
        if (fq == 0) r1[row0 + fr] = r;
#pragma unroll
        for (int j = 0; j < 4; ++j) { const float rj = __shfl(r, 4 * fq + j); const float val = acc[j] * rj; const int row = row0 + 4 * fq + j; float o;
            if (fr < 8) o = sigm_f(val);
            else { const int hh = fr - 8; const float z = val + c.dn_dt_bias[hh]; const float sp = z > 20.f ? z : log1pf(expf(z)); o = -expf(c.dn_a_log[hh]) * sp; }
            gb[(size_t)row * 16 + fr] = o; }
    }
}

constexpr int L_KS = 0, L_KT = 34816, L_VT = 68608, L_AB = 102400, L_TII = 137216, L_G = 141312;
__device__ __forceinline__ void dn_prep(const Ctx& c, int id) {
    const int bh = id >> 5, n = id & 31, b = bh >> 3, h = bh & 7, rowbase = b * T + n * CH;
    const int tid = c.tid, fr = c.fr, fq = c.fq, w = c.wave;
    bf16* ks = (bf16*)(c.lds + L_KS); bf16* kT = (bf16*)(c.lds + L_KT); bf16* vT = (bf16*)(c.lds + L_VT); bf16* Ab = (bf16*)(c.lds + L_AB); bf16* Tii = (bf16*)(c.lds + L_TII);
    float* Gs = (float*)(c.lds + L_G); float* Bs = Gs + 128; float* graw = Gs + 256;
    const float* gb = (const float*)(c.ws + WS_GB); float* Gc = (float*)(c.ws + WS_GC);
    bf16* dqkv = (bf16*)(c.ws + WS_DQ); const bf16* halo = (const bf16*)(c.ws + WS_HALO);
    if (tid < 128) { graw[tid] = gb[(size_t)(rowbase + tid) * 16 + 8 + h]; Bs[tid] = gb[(size_t)(rowbase + tid) * 16 + h]; }
    __syncthreads();
    if (tid < 128) {
        float s = graw[tid];
#pragma unroll
        for (int o = 1; o < 64; o <<= 1) { const float t = __shfl_up(s, o); if (c.lane >= o) s += t; }
        if (tid >= 64) { float tot = 0.f;
#pragma unroll 8
            for (int t = 0; t < 64; t += 4) { const f32x4 g4 = *(const f32x4*)(graw + t); tot += (g4[0] + g4[1]) + (g4[2] + g4[3]); }
            s += tot; }
        Gs[tid] = s; Gc[(size_t)id * 128 + tid] = s; }
    const int i = tid >> 2, cg = tid & 3;
    bf16* qs = Ab;
#ifndef DP_SKIP_CONV
    {
        const int cgp = tid & 15, strip = tid >> 4, col8 = 8 * cgp, i4 = 4 * strip;
#pragma unroll 1
        for (int t = 1; t < 3; ++t) {
            u32x4 raw[7];
#pragma unroll
            for (int k = 0; k < 7; ++k) { const int rr = i4 - 3 + k; u32x4 r = (u32x4){0u, 0u, 0u, 0u};
                if (rr >= 0) r = *(const u32x4*)(dqkv + (size_t)t * ((size_t)M * 1024) + (size_t)(rowbase + rr) * 1024 + h * 128 + col8);
                else if (n > 0) r = *(const u32x4*)(halo + ((size_t)(b * 32 + n - 1) * 3 + (rr + 3)) * 3072 + t * 1024 + h * 128 + col8);
                raw[k] = r; }
            f32x4 w0[4], w1[4];
#pragma unroll
            for (int k = 0; k < 4; ++k) { const float* wp = c.dn_conv_w + (size_t)k * 3072 + t * 1024 + h * 128 + col8; w0[k] = *(const f32x4*)wp; w1[k] = *(const f32x4*)(wp + 4); }
            f32x4 y0[4], y1[4]; float ssq[4];
#pragma unroll
            for (int r = 0; r < 4; ++r) { f32x4 a0 = (f32x4){0.f, 0.f, 0.f, 0.f}, a1 = a0;
#pragma unroll
                for (int k = 0; k < 4; ++k) { f32x4 x0, x1; unpack8(raw[r + k], x0, x1); a0 = a0 + x0 * w0[k]; a1 = a1 + x1 * w1[k]; }
                float sq = 0.f;
#pragma unroll
                for (int e = 0; e < 4; ++e) { a0[e] = silu_f(a0[e]); a1[e] = silu_f(a1[e]); sq += a0[e] * a0[e] + a1[e] * a1[e]; }
                y0[r] = a0; y1[r] = a1; ssq[r] = sq; }
            if (t < 2) {
#pragma unroll
                for (int r = 0; r < 4; ++r) { float sq = ssq[r]; sq += __shfl_xor(sq, 1); sq += __shfl_xor(sq, 2); sq += __shfl_xor(sq, 4); sq += __shfl_xor(sq, 8);
                    const float rn = rsqrtf(sq + EPS); y0[r] = y0[r] * rn; y1[r] = y1[r] * rn; }
            }
            u32x4 p[4];
#pragma unroll
            for (int r = 0; r < 4; ++r) p[r] = pack8(y0[r], y1[r]);
            if (t == 0) {
#pragma unroll
                for (int r = 0; r < 4; ++r) *(u32x4*)(qs + (i4 + r) * 136 + col8) = p[r];
            } else {
                if (t == 1) {
#pragma unroll
                    for (int r = 0; r < 4; ++r) *(u32x4*)(ks + (i4 + r) * 136 + col8) = p[r];
                }
                bf16* dT = (t == 1) ? kT : vT;
                const unsigned pw[4][4] = {{p[0].x, p[0].y, p[0].z, p[0].w}, {p[1].x, p[1].y, p[1].z, p[1].w}, {p[2].x, p[2].y, p[2].z, p[2].w}, {p[3].x, p[3].y, p[3].z, p[3].w}};
#pragma unroll
                for (int e = 0; e < 4; ++e) {
                    u32x2 lo, hi;
                    lo.x = (pw[0][e] & 0xffffu) | (pw[1][e] << 16); lo.y = (pw[2][e] & 0xffffu) | (pw[3][e] << 16);
                    hi.x = (pw[0][e] >> 16) | (pw[1][e] & 0xffff0000u); hi.y = (pw[2][e] >> 16) | (pw[3][e] & 0xffff0000u);
                    *(u32x2*)(dT + (col8 + 2 * e) * 132 + i4) = lo; *(u32x2*)(dT + (col8 + 2 * e + 1) * 132 + i4) = hi;
                }
            }
        }
    }
#endif
    __syncthreads();
#pragma unroll
    for (int s4 = 0; s4 < 4; ++s4) { const int idx = tid + 512 * s4, r = idx >> 4, c8 = (idx & 15) * 8;
        *(u32x4*)(dqkv + (size_t)M * 1024 + (size_t)(rowbase + r) * 1024 + h * 128 + c8) = *(const u32x4*)(ks + r * 136 + c8);
    }
    __syncthreads();
#ifndef DP_SKIP_KK
    {
        const int i0 = 16 * w; bf16x8 ai[4];
#pragma unroll
        for (int kk = 0; kk < 4; ++kk) ai[kk] = *(const bf16x8*)(ks + (i0 + fr) * 136 + 32 * kk + 8 * fq);
        const float Gi = Gs[i0 + fr], bi_ = Bs[i0 + fr];
        for (int jt = 0; jt <= w; ++jt) {
            f32x4 acc = (f32x4){0.f, 0.f, 0.f, 0.f};
#pragma unroll
            for (int kk = 0; kk < 4; ++kk) acc = mfma32(*(const bf16x8*)(ks + (16 * jt + fr) * 136 + 32 * kk + 8 * fq), ai[kk], acc);
            const f32x4 G4 = *(const f32x4*)(Gs + 16 * jt + 4 * fq); f32x4 o;
#pragma unroll
            for (int r = 0; r < 4; ++r) { const int j = 16 * jt + 4 * fq + r; o[r] = (i0 + fr > j) ? -bi_ * acc[r] * __expf(Gi - G4[r]) : 0.f; }
            *(bf16x4*)(Ab + (i0 + fr) * 136 + 16 * jt + 4 * fq) = pack4(o);
        }
    }
#endif
    __syncthreads();
#ifndef DP_SKIP_TII
    if (tid < 128) {
        const int blk = tid >> 4, cx = tid & 15; float xs[16];
#pragma unroll
        for (int r = 0; r < 16; ++r) {
            float s = (r == cx) ? 1.f : 0.f;
            const u32x4 ra = *(const u32x4*)(Ab + (16 * blk + r) * 136 + 16 * blk), rb = *(const u32x4*)(Ab + (16 * blk + r) * 136 + 16 * blk + 8);
            const unsigned rw[8] = {ra.x, ra.y, ra.z, ra.w, rb.x, rb.y, rb.z, rb.w};
#pragma unroll
            for (int s_ = 0; s_ < r; ++s_) { const float av = (s_ & 1) ? bfhi(rw[s_ >> 1]) : bflo(rw[s_ >> 1]); s += av * xs[s_]; }
            xs[r] = s; Tii[(blk * 16 + r) * 16 + cx] = f2bf(s);
            asm volatile("" ::: "memory");
        }
    }
#endif
#ifndef DP_SKIP_KD
    {
        const int d = tid >> 2, ig = tid & 3; const float Gl = Gs[127]; bf16* dst = (bf16*)(c.out) + (OUT_KDT / 2) + (size_t)id * 16384 + (size_t)((((d >> 4) * 4 + ig) * 64) + (d & 15)) * 8;
#pragma unroll
        for (int q = 0; q < 4; ++q) {
            const u32x2 r0 = *(const u32x2*)(kT + d * 132 + 32 * ig + 8 * q), r1 = *(const u32x2*)(kT + d * 132 + 32 * ig + 8 * q + 4);
            const f32x4 g0 = *(const f32x4*)(Gs + 32 * ig + 8 * q), g1 = *(const f32x4*)(Gs + 32 * ig + 8 * q + 4);
            f32x4 a = (f32x4){bflo(r0.x), bfhi(r0.x), bflo(r0.y), bfhi(r0.y)}, bb = (f32x4){bflo(r1.x), bfhi(r1.x), bflo(r1.y), bfhi(r1.y)};
#pragma unroll
            for (int e = 0; e < 4; ++e) { a[e] *= __expf(Gl - g0[e]); bb[e] *= __expf(Gl - g1[e]); }
            *(u32x4*)(dst + 128 * q) = pack8(a, bb);
        }
    }
#endif
    __syncthreads();
#ifndef DP_SKIP_SOLVE
    {
        const bool isk = w >= 4; const bf16* srcT = isk ? kT : vT; const int cb = (w & 3) * 32;
        bf16x4 X[8][2];
#pragma unroll
        for (int bi = 0; bi < 8; ++bi) {
            f32x4 bet = *(const f32x4*)(Bs + 16 * bi + 4 * fq);
            if (isk) { const f32x4 g4 = *(const f32x4*)(Gs + 16 * bi + 4 * fq); bet[0] *= __expf(g4[0]); bet[1] *= __expf(g4[1]); bet[2] *= __expf(g4[2]); bet[3] *= __expf(g4[3]); }
            f32x4 acc[2];
#pragma unroll
            for (int t = 0; t < 2; ++t) { const u32x2 raw = *(const u32x2*)(srcT + (cb + 16 * t + fr) * 132 + 16 * bi + 4 * fq);
                acc[t] = (f32x4){bflo(raw.x) * bet[0], bfhi(raw.x) * bet[1], bflo(raw.y) * bet[2], bfhi(raw.y) * bet[3]}; }
#pragma unroll
            for (int kb = 0; kb < ((DBG_SOLVE == 2 || DBG_SOLVE == 3) ? 0 : bi); ++kb) { const bf16x4 af = *(const bf16x4*)(Ab + (16 * bi + fr) * 136 + 16 * kb + 4 * fq);
                acc[0] = mfma16(af, X[kb][0], acc[0]); acc[1] = mfma16(af, X[kb][1], acc[1]); }
            const bf16x4 tf = *(const bf16x4*)(Tii + (bi * 16 + fr) * 16 + 4 * fq);
#pragma unroll
#if DBG_SOLVE == 1 || DBG_SOLVE == 3
            for (int t = 0; t < 2; ++t) X[bi][t] = pack4(acc[t]);
#else
            for (int t = 0; t < 2; ++t) X[bi][t] = pack4(mfma16(tf, pack4(acc[t]), (f32x4){0.f, 0.f, 0.f, 0.f}));
#endif
            asm volatile("" ::: "memory");
        }
        if (!isk) {
            bf16* dvp = (bf16*)(c.ws + WS_DV);
#pragma unroll
            for (int bi = 0; bi < 8; ++bi)
#pragma unroll
                for (int t = 0; t < 2; ++t) { const int cc = cb + 16 * t + fr, o = (((cc >> 4) * 8 + bi) * 16 + (cc & 15)) * 16 + 4 * fq;
                    *(bf16x4*)(dvp + (size_t)(rowbase + (o >> 7)) * 1024 + h * 128 + (o & 127)) = X[bi][t]; }
        } else {
#pragma unroll
            for (int bi = 0; bi < 8; ++bi)
#pragma unroll
                for (int t = 0; t < 2; ++t) { const u32x2 xx = __builtin_bit_cast(u32x2, X[bi][t]); const int col = cb + 16 * t + fr, r0 = 16 * bi + 4 * fq;
                    ks[(r0 + 0) * 136 + col] = (bf16)(xx.x & 0xffffu); ks[(r0 + 1) * 136 + col] = (bf16)(xx.x >> 16);
                    ks[(r0 + 2) * 136 + col] = (bf16)(xx.y & 0xffffu); ks[(r0 + 3) * 136 + col] = (bf16)(xx.y >> 16); }
        }
    }
#endif
    __syncthreads();
    {
        const int ii = tid >> 2, dg = tid & 3; bf16* dst = (bf16*)(c.out) + (OUT_W / 2) + (size_t)id * 16384 + (size_t)((((ii >> 4) * 4 + dg) * 64) + (ii & 15)) * 8;
#pragma unroll
        for (int q = 0; q < 4; ++q) *(u32x4*)(dst + 128 * q) = *(const u32x4*)(ks + ii * 136 + 32 * dg + 8 * q);
    }
    __syncthreads();
}
__device__ __forceinline__ void strip_transpose_store(bf16* dT, int ld, int c8, int j4, const u32x4 (&p)[4]) {
    const unsigned pw[4][4] = {{p[0].x, p[0].y, p[0].z, p[0].w}, {p[1].x, p[1].y, p[1].z, p[1].w}, {p[2].x, p[2].y, p[2].z, p[2].w}, {p[3].x, p[3].y, p[3].z, p[3].w}};
#pragma unroll
    for (int e = 0; e < 4; ++e) { u32x2 lo, hi;
        lo.x = (pw[0][e] & 0xffffu) | (pw[1][e] << 16); lo.y = (pw[2][e] & 0xffffu) | (pw[3][e] << 16);
        hi.x = (pw[0][e] >> 16) | (pw[1][e] & 0xffff0000u); hi.y = (pw[2][e] >> 16) | (pw[3][e] & 0xffff0000u);
        *(u32x2*)(dT + (c8 + 2 * e) * ld + j4) = lo; *(u32x2*)(dT + (c8 + 2 * e + 1) * ld + j4) = hi; }
}
__device__ __forceinline__ float ret_logg(int h) { return log1pf(-exp2f(-5.f - (float)h)); }
__device__ __forceinline__ void ret_kv(const Ctx& c, int id) {
    const int bh = id >> 5, n = id & 31, b = bh >> 3, h = bh & 7, rowbase = b * T + n * CH;
    const int tid = c.tid, fr = c.fr, fq = c.fq, w = c.wave;
    bf16* kT2 = (bf16*)c.lds; bf16* vT2 = (bf16*)(c.lds + 17408);
    const bf16* rk = (const bf16*)(c.ws + WS_RK); const bf16* rv = (const bf16*)(c.ws + WS_RV);
    const float lg = ret_logg(h);
    { const int c8 = 8 * (tid & 15), j4 = 4 * (tid >> 4); u32x4 p[4];
#pragma unroll
      for (int r = 0; r < 4; ++r) p[r] = *(const u32x4*)(rv + (size_t)(rowbase + j4 + r) * 1024 + h * 128 + c8);
      strip_transpose_store(vT2, 136, c8, j4, p); }
    if (tid < 256) { const int c8 = 8 * (tid & 7), j4 = 4 * (tid >> 3); u32x4 p[4];
#pragma unroll
      for (int r = 0; r < 4; ++r) { f32x4 a, bb; unpack8(*(const u32x4*)(rk + (size_t)(rowbase + j4 + r) * 512 + h * 64 + c8), a, bb); const float z = __expf(lg * (float)(127 - (j4 + r))); p[r] = pack8(a * z, bb * z); }
      strip_transpose_store(kT2, 136, c8, j4, p); }
    __syncthreads();
    bf16* kv = (bf16*)(c.ws + WS_KV) + (size_t)id * 8192;
#pragma unroll
    for (int dt = 0; dt < 4; ++dt) { f32x4 acc = (f32x4){0.f, 0.f, 0.f, 0.f};
#pragma unroll
        for (int kk = 0; kk < 4; ++kk) acc = mfma32(*(const bf16x8*)(kT2 + (16 * dt + fr) * 136 + 32 * kk + 8 * fq), *(const bf16x8*)(vT2 + (16 * w + fr) * 136 + 32 * kk + 8 * fq), acc);
        *(bf16x4*)(kv + (16 * w + fr) * 64 + 16 * dt + 4 * fq) = pack4(acc); }
    __syncthreads();
}

__device__ __forceinline__ void phase3(const Ctx& c) {
    const int fr = c.fr, fq = c.fq, w = c.wave, tid = c.tid;
    bf16* Sl = (bf16*)c.lds; bf16* Vl = (bf16*)(c.lds + 4352);
    const bf16* Wp0 = (const bf16*)(c.out) + (OUT_W / 2); const bf16* Kp0 = (const bf16*)(c.out) + (OUT_KDT / 2);
    bf16* dvp = (bf16*)(c.ws + WS_DV); bf16* snp = (bf16*)(c.ws + WS_SN); const float* Gc = (const float*)(c.ws + WS_GC);
    for (int wi = c.bid; wi < 256; wi += c.G) {
        const int xq = wi & 7, yq = wi >> 3, slice = yq & 7, bh = xq + 8 * (yq >> 3), b = bh >> 3, h = bh & 7;
        for (int i = tid; i < 16 * 136 / 2; i += 512) ((unsigned*)Sl)[i] = 0u;
        __syncthreads();
        f32x4 S = (f32x4){0.f, 0.f, 0.f, 0.f};
        const size_t woff = (size_t)w * 2048 + (size_t)c.lane * 8;
        const bf16* Wb = Wp0 + (size_t)(bh * 32) * 16384 + woff; const bf16* Kb = Kp0 + (size_t)(bh * 32) * 16384 + woff;
        const int o3 = ((slice * 8 + w) * 16 + fr) * 16 + 4 * fq;
        bf16* ub = dvp + (size_t)(b * T + (o3 >> 7)) * 1024 + h * 128 + (o3 & 127);
        bf16* sb = snp + (size_t)(bh * 32) * 16384 + o3;
        const float* gl = Gc + (size_t)(bh * 32) * 128 + 127;
        bf16x8 wR[4][4], kR[4][4]; bf16x4 uR[4]; float dR[4];
#define P3_LOAD(slot, n_) do { _Pragma("unroll") for (int kk = 0; kk < 4; ++kk) { wR[slot][kk] = *(const bf16x8*)(Wb + (size_t)(n_) * 16384 + 512 * kk); kR[slot][kk] = *(const bf16x8*)(Kb + (size_t)(n_) * 16384 + 512 * kk); } \
            uR[slot] = *(const bf16x4*)(ub + (size_t)(n_) * CH * 1024); dR[slot] = gl[(size_t)(n_) * 128]; } while (0)
#define P3_BAR() do { asm volatile("s_waitcnt lgkmcnt(0)" ::: "memory"); __builtin_amdgcn_s_barrier(); asm volatile("" ::: "memory"); } while (0)
#define P3_STEP(slot, n_) do { \
            *(bf16x4*)(sb + (size_t)(n_) * 16384) = pack4(S); \
            f32x4 accA = (f32x4){0.f, 0.f, 0.f, 0.f}, accB = accA; \
            accA = mfma32(wR[slot][0], *(const bf16x8*)(Sl + fr * 136 + 8 * fq), accA); accB = mfma32(wR[slot][1], *(const bf16x8*)(Sl + fr * 136 + 32 + 8 * fq), accB); \
            accA = mfma32(wR[slot][2], *(const bf16x8*)(Sl + fr * 136 + 64 + 8 * fq), accA); accB = mfma32(wR[slot][3], *(const bf16x8*)(Sl + fr * 136 + 96 + 8 * fq), accB); \
            const u32x2 ur = __builtin_bit_cast(u32x2, uR[slot]); \
            const f32x4 vn = (f32x4){bflo(ur.x) - (accA[0] + accB[0]), bfhi(ur.x) - (accA[1] + accB[1]), bflo(ur.y) - (accA[2] + accB[2]), bfhi(ur.y) - (accA[3] + accB[3])}; \
            const bf16x4 vb = pack4(vn); \
            *(bf16x4*)(ub + (size_t)(n_) * CH * 1024) = vb; \
            *(bf16x4*)(Vl + fr * 136 + 16 * w + 4 * fq) = vb; \
            P3_BAR(); \
            f32x4 acC = (f32x4){0.f, 0.f, 0.f, 0.f}, acD = acC; \
            acC = mfma32(kR[slot][0], *(const bf16x8*)(Vl + fr * 136 + 8 * fq), acC); acD = mfma32(kR[slot][1], *(const bf16x8*)(Vl + fr * 136 + 32 + 8 * fq), acD); \
            acC = mfma32(kR[slot][2], *(const bf16x8*)(Vl + fr * 136 + 64 + 8 * fq), acC); acD = mfma32(kR[slot][3], *(const bf16x8*)(Vl + fr * 136 + 96 + 8 * fq), acD); \
            S = S * __expf(dR[slot]) + (acC + acD); \
            *(bf16x4*)(Sl + fr * 136 + 16 * w + 4 * fq) = pack4(S); \
            P3_BAR(); } while (0)
        P3_LOAD(0, 0); P3_LOAD(1, 1); P3_LOAD(2, 2); P3_LOAD(3, 3);
#pragma unroll
        for (int n4 = 0; n4 < NCH; n4 += 4) {
            const int np = (n4 + 4 < NCH) ? 4 : 0;
            P3_STEP(0, n4);     P3_LOAD(0, n4 + np);
            P3_STEP(1, n4 + 1); P3_LOAD(1, n4 + np + (np ? 1 : 0));
            P3_STEP(2, n4 + 2); P3_LOAD(2, n4 + np + (np ? 2 : 0));
            P3_STEP(3, n4 + 3); P3_LOAD(3, n4 + np + (np ? 3 : 0));
        }
#undef P3_LOAD
#undef P3_STEP
#undef P3_BAR
        __syncthreads();
    }
    for (int gid = c.bid * 512 + tid; gid < 32 * 4096; gid += c.G * 512) {
        const int bh = gid >> 12, e = gid & 4095, h = bh & 7; const float decay = __expf(128.f * ret_logg(h));
        unsigned* p = (unsigned*)(c.ws + WS_KV) + (size_t)(bh * 32) * 4096 + e; float s0 = 0.f, s1 = 0.f;
#pragma unroll 8
        for (int n = 0; n < NCH; ++n) { const unsigned raw = p[(size_t)n * 4096]; p[(size_t)n * 4096] = pk2(s0, s1); s0 = s0 * decay + bflo(raw); s1 = s1 * decay + bfhi(raw); }
    }
}

struct DnPre { u32x4 kk[4], vv[4], ss[4], qraw[7]; float g; };
__device__ __forceinline__ void dn_out_load(const Ctx& c, int id, DnPre& p) {
    const int bh = id >> 5, n = id & 31, b = bh >> 3, h = bh & 7, rowbase = b * T + n * CH; const int tid = c.tid, fr = c.fr, fq = c.fq, w = c.wave;
    const bf16* dq = (const bf16*)(c.ws + WS_DQ); const bf16* dk = (const bf16*)(c.ws + WS_DK); const bf16* dv = (const bf16*)(c.ws + WS_DV); const bf16* sn = (const bf16*)(c.ws + WS_SN) + (size_t)id * 16384;
#pragma unroll
    for (int s = 0; s < 4; ++s) { const int idx = tid + 512 * s, r = idx >> 4, c8 = (idx & 15) * 8;
        const int o = 8 * idx;
        p.kk[s] = *(const u32x4*)(dk + (size_t)(rowbase + r) * 1024 + h * 128 + c8); p.vv[s] = *(const u32x4*)(dv + (size_t)(rowbase + (o >> 7)) * 1024 + h * 128 + (o & 127)); p.ss[s] = *(const u32x4*)(sn + o); }
    { const bf16* halo = (const bf16*)(c.ws + WS_HALO); const int col8 = 8 * (tid & 15), i4 = 4 * (tid >> 4);
#pragma unroll
      for (int k = 0; k < 7; ++k) { const int rr = i4 - 3 + k; u32x4 r = (u32x4){0u, 0u, 0u, 0u};
          if (rr >= 0) r = *(const u32x4*)(dq + (size_t)(rowbase + rr) * 1024 + h * 128 + col8);
          else if (n > 0) r = *(const u32x4*)(halo + ((size_t)(b * 32 + n - 1) * 3 + (rr + 3)) * 3072 + h * 128 + col8);
          p.qraw[k] = r; } }
    p.g = (tid < 128) ? ((const float*)(c.ws + WS_GC))[(size_t)id * 128 + tid] : 0.f;
}
__device__ __forceinline__ void dn_out(const Ctx& c, int id, int next_id, DnPre& p) {
    const int bh = id >> 5, n = id & 31, b = bh >> 3, h = bh & 7, rowbase = b * T + n * CH;
    const int tid = c.tid, fr = c.fr, fq = c.fq, w = c.wave;
    bf16* ksl = (bf16*)c.lds; bf16* snl = (bf16*)(c.lds + 34816); bf16* vl = (bf16*)(c.lds + 69632); float* Gs = (float*)(c.lds + 104448);
    bf16* dv = (bf16*)(c.ws + WS_DV);
#pragma unroll
    for (int s = 0; s < 4; ++s) { const int idx = tid + 512 * s, r = idx >> 4, c8 = (idx & 15) * 8;
        const int o = 8 * idx, cT = (((o >> 11) & 7) << 4) | ((o >> 4) & 15), iT = (((o >> 8) & 7) << 4) | (o & 15);
        *(u32x4*)(ksl + r * 136 + c8) = p.kk[s]; *(u32x4*)(vl + cT * 136 + iT) = p.vv[s]; *(u32x4*)(snl + cT * 136 + iT) = p.ss[s]; }
    if (tid < 128) Gs[tid] = p.g;
    bf16* qsl = (bf16*)(c.lds + 104960);
    { const int col8 = 8 * (tid & 15), i4 = 4 * (tid >> 4);
      f32x4 w0[4], w1[4];
#pragma unroll
      for (int k = 0; k < 4; ++k) { const float* wp = c.dn_conv_w + (size_t)k * 3072 + h * 128 + col8; w0[k] = *(const f32x4*)wp; w1[k] = *(const f32x4*)(wp + 4); }
#pragma unroll
      for (int r = 0; r < 4; ++r) { f32x4 a0 = (f32x4){0.f, 0.f, 0.f, 0.f}, a1 = a0;
#pragma unroll
          for (int k = 0; k < 4; ++k) { f32x4 x0, x1; unpack8(p.qraw[r + k], x0, x1); a0 = a0 + x0 * w0[k]; a1 = a1 + x1 * w1[k]; }
          float sq = 0.f;
#pragma unroll
          for (int e = 0; e < 4; ++e) { a0[e] = silu_f(a0[e]); a1[e] = silu_f(a1[e]); sq += a0[e] * a0[e] + a1[e] * a1[e]; }
          sq += __shfl_xor(sq, 1); sq += __shfl_xor(sq, 2); sq += __shfl_xor(sq, 4); sq += __shfl_xor(sq, 8);
          const float rn = rsqrtf(sq + EPS);
          *(u32x4*)(qsl + (i4 + r) * 136 + col8) = pack8(a0 * rn, a1 * rn); } }
    __syncthreads();
    dn_out_load(c, next_id, p);
    const int i0 = 16 * w, i = i0 + fr; const float scale = 0.08838834764831845f;
    bf16x8 qA[4];
#pragma unroll
    for (int kk = 0; kk < 4; ++kk) qA[kk] = *(const bf16x8*)(qsl + i * 136 + 32 * kk + 8 * fq);
    const float Gi = Gs[i], rowsc = __expf(Gi) * scale;
    f32x4 O[8];
#pragma unroll
    for (int ct = 0; ct < 8; ++ct) { f32x4 acc = (f32x4){0.f, 0.f, 0.f, 0.f};
#pragma unroll
        for (int kk = 0; kk < 4; ++kk) acc = mfma32(*(const bf16x8*)(snl + (16 * ct + fr) * 136 + 32 * kk + 8 * fq), qA[kk], acc);
        O[ct] = acc * rowsc; }
    for (int jt = 0; jt <= w; ++jt) {
        f32x4 p = (f32x4){0.f, 0.f, 0.f, 0.f};
#pragma unroll
        for (int kk = 0; kk < 4; ++kk) p = mfma32(*(const bf16x8*)(ksl + (16 * jt + fr) * 136 + 32 * kk + 8 * fq), qA[kk], p);
        const f32x4 G4 = *(const f32x4*)(Gs + 16 * jt + 4 * fq);
#pragma unroll
        for (int r = 0; r < 4; ++r) { const int j = 16 * jt + 4 * fq + r; p[r] = (i >= j) ? p[r] * scale * __expf(Gi - G4[r]) : 0.f; }
        const bf16x4 pb = pack4(p);
#pragma unroll
        for (int ct = 0; ct < 8; ++ct) O[ct] = mfma16(*(const bf16x4*)(vl + (16 * ct + fr) * 136 + 16 * jt + 4 * fq), pb, O[ct]);
    }
    float ssq = 0.f;
#pragma unroll
    for (int ct = 0; ct < 8; ++ct) ssq += (O[ct][0] * O[ct][0] + O[ct][1] * O[ct][1]) + (O[ct][2] * O[ct][2] + O[ct][3] * O[ct][3]);
    ssq += __shfl_xor(ssq, 16); ssq += __shfl_xor(ssq, 32);
    const float rstd = rsqrtf(ssq * (1.f / 128.f) + EPS);
#pragma unroll
    for (int ct = 0; ct < 8; ++ct) { const int cc = 16 * ct + 4 * fq; const f32x4 g4 = *(const f32x4*)(c.dn_norm_g + cc);
        *(bf16x4*)(dv + (size_t)(rowbase + i) * 1024 + h * 128 + cc) = pack4(O[ct] * rstd * g4); }
    __syncthreads();
}
__device__ __forceinline__ void ret_out(const Ctx& c, int id) {
    const int bh = id >> 5, n = id & 31, b = bh >> 3, h = bh & 7, rowbase = b * T + n * CH;
    const int tid = c.tid, fr = c.fr, fq = c.fq, w = c.wave;
    bf16* ksl = (bf16*)c.lds; bf16* snl = (bf16*)(c.lds + 18432); bf16* vl = (bf16*)(c.lds + 36864);
    const bf16* rq = (const bf16*)(c.ws + WS_RQ); const bf16* rk = (const bf16*)(c.ws + WS_RK); bf16* rv = (bf16*)(c.ws + WS_RV); const bf16* sp = (const bf16*)(c.ws + WS_KV) + (size_t)id * 8192;
#pragma unroll
    for (int s = 0; s < 2; ++s) { const int idx = tid + 512 * s, r = idx >> 3, c8 = (idx & 7) * 8;
        *(u32x4*)(ksl + r * 72 + c8) = *(const u32x4*)(rk + (size_t)(rowbase + r) * 512 + h * 64 + c8);
        *(u32x4*)(snl + r * 72 + c8) = *(const u32x4*)(sp + r * 64 + c8); }
    { const int c8 = 8 * (tid & 15), j4 = 4 * (tid >> 4); u32x4 p[4];
#pragma unroll
      for (int r = 0; r < 4; ++r) p[r] = *(const u32x4*)(rv + (size_t)(rowbase + j4 + r) * 1024 + h * 128 + c8);
      strip_transpose_store(vl, 136, c8, j4, p); }
    __syncthreads();
    const int i0 = 16 * w, i = i0 + fr; const float lg = ret_logg(h);
    bf16x8 qA[2];
#pragma unroll
    for (int kk = 0; kk < 2; ++kk) qA[kk] = *(const bf16x8*)(rq + (size_t)(rowbase + i) * 512 + h * 64 + 32 * kk + 8 * fq);
    const float xi = __expf(lg * (float)(i + 1));
    f32x4 O[8];
#pragma unroll
    for (int ct = 0; ct < 8; ++ct) { f32x4 acc = (f32x4){0.f, 0.f, 0.f, 0.f};
#pragma unroll
        for (int kk = 0; kk < 2; ++kk) acc = mfma32(*(const bf16x8*)(snl + (16 * ct + fr) * 72 + 32 * kk + 8 * fq), qA[kk], acc);
        O[ct] = acc * xi; }
    for (int jt = 0; jt <= w; ++jt) {
        f32x4 p = (f32x4){0.f, 0.f, 0.f, 0.f};
#pragma unroll
        for (int kk = 0; kk < 2; ++kk) p = mfma32(*(const bf16x8*)(ksl + (16 * jt + fr) * 72 + 32 * kk + 8 * fq), qA[kk], p);
#pragma unroll
        for (int r = 0; r < 4; ++r) { const int j = 16 * jt + 4 * fq + r; p[r] = (i >= j) ? p[r] * __expf(lg * (float)(i - j)) : 0.f; }
        const bf16x4 pb = pack4(p);
#pragma unroll
        for (int ct = 0; ct < 8; ++ct) O[ct] = mfma16(*(const bf16x4*)(vl + (16 * ct + fr) * 136 + 16 * jt + 4 * fq), pb, O[ct]);
    }
    float sm = 0.f;
#pragma unroll
    for (int ct = 0; ct < 8; ++ct) sm += (O[ct][0] + O[ct][1]) + (O[ct][2] + O[ct][3]);
    sm += __shfl_xor(sm, 16); sm += __shfl_xor(sm, 32);
    const float mu = sm * (1.f / 128.f); float vs = 0.f;
#pragma unroll
    for (int ct = 0; ct < 8; ++ct) { O[ct] = O[ct] - mu; vs += (O[ct][0] * O[ct][0] + O[ct][1] * O[ct][1]) + (O[ct][2] * O[ct][2] + O[ct][3] * O[ct][3]); }
    vs += __shfl_xor(vs, 16); vs += __shfl_xor(vs, 32);
    const float rstd = rsqrtf(vs * (1.f / 128.f) + GN_EPS);
#pragma unroll
    for (int ct = 0; ct < 8; ++ct) { const int cc = 16 * ct + 4 * fq; const f32x4 g4 = *(const f32x4*)(c.ret_norm_g + h * 128 + cc);
        *(bf16x4*)(rv + (size_t)(rowbase + i) * 1024 + h * 128 + cc) = pack4(O[ct] * rstd * g4); }
    __syncthreads();
}

__device__ __forceinline__ void ffn_fixup(const Ctx& c, int pm) {
    bf16* act = (bf16*)(c.ws + WS_ACT); const bf16* hbuf = (const bf16*)(c.ws + WS_HBUF);
    constexpr int NJ4 = DFF / 4;
    for (int idx = c.tid; idx < 8 * NJ4; idx += 512) {
        const int j0 = (idx % NJ4) * 4, gr = idx / NJ4, g = 4 * pm + (gr >> 1), r = gr & 1, col = 2 * j0;
        const bool first = ((g * 64) & (T - 1)) == 0;
        u32x4 u0, u1 = (u32x4){0u, 0u, 0u, 0u}, u2 = u1;
        u0 = *(const u32x4*)(hbuf + ((size_t)g * 4 + r) * NUP + col);
        if (r == 1) { u1 = *(const u32x4*)(hbuf + ((size_t)g * 4 + 0) * NUP + col); if (!first) u2 = *(const u32x4*)(hbuf + ((size_t)(g - 1) * 4 + 3) * NUP + col); }
        else if (!first) { u1 = *(const u32x4*)(hbuf + ((size_t)(g - 1) * 4 + 3) * NUP + col); u2 = *(const u32x4*)(hbuf + ((size_t)(g - 1) * 4 + 2) * NUP + col); }
        f32x4 c0, c1, p10, p11, p20, p21; unpack8(u0, c0, c1); unpack8(u1, p10, p11); unpack8(u2, p20, p21);
        f32x4 wa[3], wb[3];
#pragma unroll
        for (int k = 0; k < 3; ++k) { wa[k] = *(const f32x4*)(c.ffn_conv_w + (size_t)k * NUP + j0); wb[k] = *(const f32x4*)(c.ffn_conv_w + (size_t)k * NUP + DFF + j0); }
        const f32x4 ba = *(const f32x4*)(c.ffn_conv_b + j0), bb = *(const f32x4*)(c.ffn_conv_b + DFF + j0);
        const f32x4 xa = (f32x4){c0[0], c0[2], c1[0], c1[2]}, xb = (f32x4){c0[1], c0[3], c1[1], c1[3]};
        const f32x4 xa1 = (f32x4){p10[0], p10[2], p11[0], p11[2]}, xb1 = (f32x4){p10[1], p10[3], p11[1], p11[3]};
        const f32x4 xa2 = (f32x4){p20[0], p20[2], p21[0], p21[2]}, xb2 = (f32x4){p20[1], p20[3], p21[1], p21[3]};
        const f32x4 ya = wa[0] * xa2 + wa[1] * xa1 + wa[2] * xa + ba, yb = wb[0] * xb2 + wb[1] * xb1 + wb[2] * xb + bb;
        f32x4 o;
#pragma unroll
        for (int e = 0; e < 4; ++e) o[e] = silu_f(ya[e]) * yb[e];
        *(bf16x4*)(act + (size_t)(g * 64 + r) * DFF + j0) = pack4(o);
    }
}

#define XB_TMO      128
#define XB_XCNT(j)  (256  + 64 * (j))
#define XB_XSUB(j)  (1280 + 64 * (j))
#define XB_XGEN(j)  (2304 + 64 * (j))
#define XB_TOP      3328
#define XB_TOPGEN   3392
#define XCD_BAR_WORDS 3456
#define XB_SPIN_CAP (1u << 18)

__device__ __forceinline__ unsigned xb_ld(unsigned* p)              { return __hip_atomic_load(p, __ATOMIC_RELAXED, __HIP_MEMORY_SCOPE_AGENT); }
__device__ __forceinline__ unsigned xb_add(unsigned* p, unsigned v) { return __hip_atomic_fetch_add(p, v, __ATOMIC_RELAXED, __HIP_MEMORY_SCOPE_AGENT); }
__device__ __forceinline__ unsigned xb_xcc_id() { return (unsigned)__builtin_amdgcn_s_getreg((3 << 11) | 20) & 0xFu; }
#define XB_SPIN(cond, bar) do { unsigned _sp = 0; while (cond) { __builtin_amdgcn_s_sleep(1); \
    if ((++_sp & 255u) == 0u) { if (xb_ld(&(bar)[XB_TMO])) break; if (_sp > XB_SPIN_CAP) { atomicAdd(&(bar)[XB_TMO], 1u); break; } } } } while (0)

struct XcdBarrier {
    unsigned* bar; unsigned x;
    volatile PG8_LAS unsigned* st;
};

__device__ __forceinline__ XcdBarrier xcd_barrier_post(unsigned* bar, volatile PG8_LAS unsigned* st) {
    XcdBarrier b; b.bar = bar; b.x = xb_xcc_id(); b.st = st;
    if (threadIdx.x == 0) (void)xb_add(&bar[XB_XCNT(b.x)], 1u);
    return b;
}
__device__ __forceinline__ void xcd_barrier_complete(unsigned* bar, unsigned x, unsigned& nloc, unsigned& nx) {
    const unsigned G = gridDim.x * gridDim.y * gridDim.z;
    unsigned sum, cnt, mine, sp = 0u;
    for (;;) {
        sum = 0u; cnt = 0u; mine = 0u;
#pragma unroll
        for (unsigned j = 0; j < 16; ++j) { const unsigned c = xb_ld(&bar[XB_XCNT(j)]); sum += c; cnt += (c > 0u) ? 1u : 0u; mine = (j == x) ? c : mine; }
        if (sum == G) break;
        __builtin_amdgcn_s_sleep(1);
        if ((++sp & 255u) == 0u) { if (xb_ld(&bar[XB_TMO])) break; if (sp > XB_SPIN_CAP) { atomicAdd(&bar[XB_TMO], 1u); break; } }
    }
    nloc = mine > 0u ? mine : 1u; nx = cnt > 0u ? cnt : 1u;
}

__device__ __forceinline__ void xcd_barrier(const XcdBarrier& b) {
    asm volatile("s_waitcnt vmcnt(0)" ::: "memory");
    __syncthreads();
    if (threadIdx.x == 0) {
        unsigned* bar = b.bar;
        __builtin_amdgcn_s_waitcnt(0);
        unsigned nloc = b.st[0], nx = b.st[1];
        if (nloc == 0u) { xcd_barrier_complete(bar, b.x, nloc, nx); b.st[0] = nloc; b.st[1] = nx; }
        const unsigned old = xb_add(&bar[XB_XSUB(b.x)], 1u);
        const unsigned gen = old / nloc;
        if (old + 1u == (gen + 1u) * nloc) {
            __builtin_amdgcn_fence(__ATOMIC_RELEASE, "agent");
            asm volatile("s_waitcnt vmcnt(0)" ::: "memory");
            const unsigned og = xb_add(&bar[XB_TOP], 1u);
            const unsigned tg = og / nx;
            if (og + 1u == (tg + 1u) * nx) xb_add(&bar[XB_TOPGEN], 1u);
            else XB_SPIN(xb_ld(&bar[XB_TOPGEN]) == tg, bar);
            __builtin_amdgcn_fence(__ATOMIC_ACQUIRE, "agent");
            xb_add(&bar[XB_XGEN(b.x)], 1u);
            asm volatile("s_waitcnt vmcnt(0)" ::: "memory");
        } else {
            XB_SPIN(xb_ld(&bar[XB_XGEN(b.x)]) == gen, bar);
            __builtin_amdgcn_fence(__ATOMIC_ACQUIRE, "agent");
            asm volatile("s_waitcnt vmcnt(0)" ::: "memory");
        }
    }
    __syncthreads();
}

struct PairOrder {
    pg8::StaticOrder base;
    __device__ bool next(int i, pg8::Unit& u) const { if (!base.next(i >> 1, u)) return false; if (i & 1) { u.pm += 192; u.pn += 4; } return true; }
    __device__ __forceinline__ void a_ready(const pg8::Unit&) const {}
    __device__ __forceinline__ void done(const pg8::Unit&) const {}
};
struct Epi6 {
    static constexpr bool PERM = true, AFTER_DRAIN = false; bf16* sigr; const bf16* sigd;
    __device__ __forceinline__ void operator()(const pg8::f32x4 (&acc)[2][2][4][2], const pg8::Unit& u, int wr, int wc, int fr, int fq) const {
        const bool second = u.pn >= 4; const int pm = second ? u.pm - 192 : u.pm, pn = second ? u.pn - 4 : u.pn;
#pragma unroll
        for (int ai = 0; ai < 2; ++ai)
#pragma unroll
            for (int m = 0; m < 4; ++m) { const int row = pm * 256 + ai * 128 + wr * 64 + m * 16 + fr;
#pragma unroll
                for (int bj = 0; bj < 2; ++bj) { const int col = pn * 256 + bj * 128 + wc * 32 + 8 * fq; bf16* p = sigr + (size_t)row * 1024 + col;
                    f32x4 a, b; unpack8(*(const u32x4*)p, a, b);
                    if (!second) { a = a * acc[ai][bj][m][0]; b = b * acc[ai][bj][m][1]; }
                    else { f32x4 s0, s1; unpack8(*(const u32x4*)(sigd + (size_t)row * 1024 + col), s0, s1); a = a + s0 * acc[ai][bj][m][0]; b = b + s1 * acc[ai][bj][m][1]; }
                    *(u32x4*)p = pack8(a, b); } }
    }
};
template <int K> __device__ __forceinline__ void run_phase(const Ctx& c, unsigned char* lds, PG8_LAS unsigned char* ldsl, unsigned char* ws, bf16* outb) {

    if constexpr (K == 0) phase0(c);
    if constexpr (K == 1) {
        pg8::Gemm g{(const bf16*)(ws + WS_UX), (const bf16*)(ws + WS_WIN) + (size_t)N5 * 1024, M, N1, 1024, 1024, 1024}; pg8::StaticOrder S; S.init(M, N1, c.G, c.bid);
        EpiRow8<F1> E{F1{(const float*)(ws + WS_R1), (const float*)(ws + WS_ROPE), (bf16*)(ws + WS_RQ), (bf16*)(ws + WS_RK), (bf16*)(ws + WS_RV), (bf16*)(ws + WS_DQ), (bf16*)(ws + WS_HALO)}};
        pg8::gemm_phase<EpiRow8<F1>, pg8::StaticOrder, true, true>(ldsl, g, S, E);
    }
    if constexpr (K == 2) {
        for (int id = c.bid; id < 1024; id += c.G) dn_prep(c, id);
        for (int id = c.bid; id < 1024; id += c.G) ret_kv(c, id);
    }
    if constexpr (K == 3) phase3(c);
    if constexpr (K == 4) {
#ifndef DBG_SKIP_OUT
        { DnPre pre; if (c.bid < 1024) dn_out_load(c, c.bid, pre);
          for (int id = c.bid; id < 1024; id += c.G) dn_out(c, id, (id + c.G < 1024) ? id + c.G : id, pre); }
        for (int id = c.bid; id < 1024; id += c.G) ret_out(c, id);
#endif
    }
    if constexpr (K == 5) {
        {
          float* scr = (float*)(lds + c.wave * 16384); const int gw = c.bid * 8 + c.wave, ngw = c.G * 8;
          constexpr int I_SQ = 16 * 32, I_UP = 16 * (NUP / 32), I_DN = (DFF / 64) * 32;
          for (int it = gw; it < 3 * I_SQ + I_UP + I_DN; it += ngw) {
              if (it < I_SQ) transpose_item<0>(c.w_ret_br, 1024, 1024, (bf16*)(ws + WS_WRET), nullptr, scr, it, 32, c.lane);
              else if (it < 2 * I_SQ) transpose_item<0>(c.w_dn_br, 1024, 1024, (bf16*)(ws + WS_WDN), nullptr, scr, it - I_SQ, 32, c.lane);
              else if (it < 3 * I_SQ) transpose_item<0>(c.w_o, 1024, 1024, (bf16*)(ws + WS_WO), nullptr, scr, it - 2 * I_SQ, 32, c.lane);
              else if (it < 3 * I_SQ + I_UP) transpose_item<2>(c.w_up, 1024, NUP, (bf16*)(ws + WS_WUP), c.g_ffn, scr, it - 3 * I_SQ, NUP / 32, c.lane);
              else transpose_item<0>(c.w_down, DFF, 1024, (bf16*)(ws + WS_WDOWN), nullptr, scr, it - 3 * I_SQ - I_UP, 32, c.lane); }
          __syncthreads(); }
        pg8::Gemm g{(const bf16*)(ws + WS_UX), (const bf16*)(ws + WS_WIN), M, N5, 1024, 1024, 1024}; pg8::StaticOrder S; S.init(M, N5, c.G, c.bid);
        EpiRow8<F5> E{F5{(const float*)(ws + WS_R1), (bf16*)(ws + WS_RV), (bf16*)(ws + WS_DV), (bf16*)(ws + WS_DQ), (bf16*)(ws + WS_DK)}};
        pg8::gemm_phase<EpiRow8<F5>, pg8::StaticOrder, true, true>(ldsl, g, S, E);
    }
    if constexpr (K == 6) {
        static_assert(WS_DV - WS_RV == (size_t)192 * 256 * 1024 * 2 && WS_WDN - WS_WRET == (size_t)4 * 256 * 1024 * 2, "tile offsets of the second GEMM");
        PairOrder S; S.base.init(M, 1024, c.G, c.bid);
        pg8::Gemm g{(const bf16*)(ws + WS_RV), (const bf16*)(ws + WS_WRET), M, 1024, 1024, 1024, 1024};
        Epi6 E{(bf16*)(ws + WS_DQ), (const bf16*)(ws + WS_DK)};
        pg8::gemm_phase<Epi6, PairOrder, true, true>(ldsl, g, S, E);
    }
    if constexpr (K == 7) {
        pg8::Gemm g{(const bf16*)(ws + WS_DQ), (const bf16*)(ws + WS_WO), M, 1024, 1024, 1024, 1024}; pg8::StaticOrder S; S.init(M, 1024, c.G, c.bid);
        EpiRes<true> E{c.x, (bf16*)(ws + WS_H1B), (float*)(ws + WS_SS1)};
        pg8::gemm_phase<EpiRes<true>, pg8::StaticOrder, true, true>(ldsl, g, S, E);
    }
    if constexpr (K == 8) {
        pg8::Gemm g{(const bf16*)(ws + WS_H1B), (const bf16*)(ws + WS_WUP), M, NUP, 1024, 1024, 1024}; pg8::StaticOrder S; S.init(M, NUP, c.G, c.bid);
        Epi8 E{(const float*)(ws + WS_SS1), (bf16*)(ws + WS_ACT), (bf16*)(ws + WS_HBUF), c.ffn_conv_w, c.ffn_conv_b};
        pg8::gemm_phase<Epi8, pg8::StaticOrder, true, true>(ldsl, g, S, E);
#ifdef TIMING_DUP_P8
        __syncthreads();
        pg8::gemm_phase<Epi8, pg8::StaticOrder, true, true>(ldsl, g, S, E);
#endif
    }
    if constexpr (K == 10) {
        pg8::Gemm g{(const bf16*)(ws + WS_ACT), (const bf16*)(ws + WS_WDOWN), M, 1024, DFF, DFF, DFF}; pg8::StaticOrder S; S.init(M, 1024, c.G, c.bid);
        { pg8::Unit u; int last_pm = -1; for (int i = 0; S.next(i, u); ++i) if (u.pm != last_pm) { ffn_fixup(c, u.pm); last_pm = u.pm; }
          asm volatile("s_waitcnt vmcnt(0)" ::: "memory"); __syncthreads(); }
        EpiRes<false> E{nullptr, (bf16*)(ws + WS_H1B), (float*)(ws + WS_SS2)};
        pg8::gemm_phase<EpiRes<false>, pg8::StaticOrder, true, true>(ldsl, g, S, E);
    }
    if constexpr (K == 11) {
        const float* ss2 = (const float*)(ws + WS_SS2);
        for (int row = c.bid * 8 + c.wave; row < M; row += c.G * 8) {
            const float pv = (c.lane < 16) ? ss2[(size_t)row * 16 + c.lane] : 0.f; float s = pv;
#pragma unroll
            for (int o = 1; o < 16; o <<= 1) s += __shfl_xor(s, o);
            s = __shfl(s, 0);
            const float r = rsqrtf(s * (1.f / 1024.f) + EPS);
            f32x4* p = (f32x4*)(c.out + (size_t)row * 1024) + 2 * c.lane; const u32x4* hp = (const u32x4*)((const bf16*)(ws + WS_H1B) + (size_t)row * 1024) + c.lane;
#pragma unroll
            for (int j = 0; j < 2; ++j) { f32x4 a0, a1; unpack8(hp[64 * j], a0, a1);
                const f32x4 g0 = *((const f32x4*)c.g_final + 128 * j + 2 * c.lane), g1 = *((const f32x4*)c.g_final + 128 * j + 2 * c.lane + 1);
                p[128 * j] = a0 * r * g0; p[128 * j + 1] = a1 * r * g1; }
        }
    }

}
struct Args { const float* in[17]; float* out; unsigned char* ws; int ph_lo, ph_hi; };
__global__ void __launch_bounds__(512) fwd_kernel(Args args) {
    extern __shared__ __attribute__((aligned(16))) unsigned char lds[];
    cg::grid_group grid = cg::this_grid();
    Ctx c;
    c.x = args.in[0]; c.g_mix = args.in[1]; c.w_in = args.in[2]; c.ret_norm_g = args.in[3]; c.dn_conv_w = args.in[4]; c.dn_a_log = args.in[5]; c.dn_dt_bias = args.in[6]; c.dn_norm_g = args.in[7];
    c.w_ret_br = args.in[8]; c.w_dn_br = args.in[9]; c.w_o = args.in[10]; c.g_ffn = args.in[11]; c.w_up = args.in[12]; c.ffn_conv_w = args.in[13]; c.ffn_conv_b = args.in[14]; c.w_down = args.in[15]; c.g_final = args.in[16];
    c.out = args.out; c.ws = args.ws; c.lds = lds;
    c.tid = threadIdx.x; c.lane = c.tid & 63; c.wave = __builtin_amdgcn_readfirstlane(c.tid >> 6); c.bid = blockIdx.x; c.G = gridDim.x; c.fr = c.lane & 15; c.fq = c.lane >> 4;
    PG8_LAS unsigned char* ldsl = (PG8_LAS unsigned char*)lds;
    const int lo = args.ph_lo, hi = args.ph_hi;
    unsigned char* ws = args.ws;
    bf16* outb = (bf16*)args.out;
#ifndef PROGRAM_STEPS
#define PROGRAM_STEPS STEP(0, 0) STEP(1, 1) STEP(2, 2) STEP(3, 3) STEP(4, 4) STEP(5, 5) STEP(6, 6) STEP(7, 7) STEP(8, 8) STEP(9, 10) STEP(10, 11)
#endif
    volatile PG8_LAS unsigned* bst = (volatile PG8_LAS unsigned*)(ldsl + LDS_BYTES - 64);
    if (c.tid < 16) bst[c.tid] = 0u;
    __syncthreads();
    XcdBarrier bar = xcd_barrier_post((unsigned*)(ws + WS_CTL), bst);
    if (lo == 0 && hi > 1) grid.sync();
#define STEP(i, k) if (lo <= (i) && (i) < hi) run_phase<k>(c, lds, ldsl, ws, outb); if (lo <= (i) && (i) + 1 < hi) xcd_barrier(bar);
    PROGRAM_STEPS
#undef STEP
#ifdef DBG_DUMP_OFF
    if (lo == 12) {
        const bf16* src = (const bf16*)(ws + (size_t)DBG_DUMP_OFF);
        for (size_t idx = (size_t)c.bid * 512 + c.tid; idx < (size_t)M * 1024; idx += (size_t)c.G * 512) { float v = bf2f(src[idx]); c.out[idx] = (v == v && fabsf(v) < 1e30f) ? v : 12345.f; }
    }
#endif
}

extern "C" void kernel_launch(void* const* d_in, const int* in_sizes, int n_in, void* d_out, int out_size, void* d_ws, size_t ws_size, hipStream_t stream) {
    static int grid = 0;
    if (grid == 0) {
        if (n_in != 17 || out_size != M * D || ws_size < WS_END) { fprintf(stderr, "kernel_launch: unexpected shapes (n_in %d out %d ws %zu)\n", n_in, out_size, ws_size); grid = -1; return; }
        int dev = 0, cus = 0, per_cu = 0;
        if (hipGetDevice(&dev) != hipSuccess || hipDeviceGetAttribute(&cus, hipDeviceAttributeMultiprocessorCount, dev) != hipSuccess) { grid = -1; return; }
        if (hipFuncSetAttribute((const void*)fwd_kernel, hipFuncAttributeMaxDynamicSharedMemorySize, LDS_BYTES) != hipSuccess) { fprintf(stderr, "kernel_launch: hipFuncSetAttribute failed\n"); grid = -1; return; }
        if (hipOccupancyMaxActiveBlocksPerMultiprocessor(&per_cu, (const void*)fwd_kernel, 512, LDS_BYTES) != hipSuccess || per_cu < 1) { fprintf(stderr, "kernel_launch: occupancy query says %d\n", per_cu); per_cu = 1; }
        (void)hipGetLastError();
        grid = cus;
    }
    if (grid < 0) return;
    Args a{};
    for (int i = 0; i < 17; ++i) a.in[i] = (const float*)d_in[i];
    a.out = (float*)d_out; a.ws = (unsigned char*)d_ws;
#if N_LAUNCH_MODE == 1
    if (hipMemsetAsync((char*)d_ws + WS_CTL, 0, CTL_BYTES, stream) != hipSuccess) { fprintf(stderr, "kernel_launch: memset of the barrier words failed\n"); return; }
    a.ph_lo = 0; a.ph_hi = NPHASE;
    void* kargs[] = {&a};
    hipError_t e = hipLaunchCooperativeKernel((const void*)fwd_kernel, dim3(grid), dim3(512), kargs, LDS_BYTES, stream);
    if (e != hipSuccess) fprintf(stderr, "kernel_launch: cooperative launch failed: %s (grid %d)\n", hipGetErrorString(e), grid);
#else
    for (int ph = 0; ph < NPHASE; ++ph) { a.ph_lo = ph; a.ph_hi = ph + 1; hipLaunchKernelGGL(fwd_kernel, dim3(grid), dim3(512), LDS_BYTES, stream, a); }
#ifdef DBG_DUMP_OFF
    a.ph_lo = 12; a.ph_hi = 13; hipLaunchKernelGGL(fwd_kernel, dim3(grid), dim3(512), LDS_BYTES, stream, a);
#endif
#endif
}
```

```cpp
#include <hip/hip_runtime.h>
#include <hip/hip_cooperative_groups.h>
#include <cstdio>
#include <cstdint>
namespace cg = cooperative_groups;
namespace pg8 {
#define PG8_LAS __attribute__((address_space(3)))
typedef unsigned short bf16_t;
typedef short bf16x8 __attribute__((ext_vector_type(8)));
typedef float f32x4 __attribute__((ext_vector_type(4)));
typedef unsigned u32x4 __attribute__((ext_vector_type(4)));
constexpr int BM = 256, BK = 64, HALF = 128, HTB = HALF * BK * 2  , STAGE_BYTES = 8 * HTB, NXCD = 8, WGM = 4;

__host__ __device__ __forceinline__ int lds_byte(int r, int c) { const int st = (r >> 4) * 2 + (c >> 5), rr = r & 15, cc = c & 31, ob = rr * 64 + cc * 2; return st * 1024 + (ob ^ (((ob >> 9) & 1) << 5)); }
__host__ __device__ __forceinline__ void stage_rc(int b, int& R, int& C) { const int st = b / 1024, sb = b % 1024, swz = sb ^ (((sb >> 9) & 1) << 5); R = (st >> 1) * 16 + swz / 64; C = (st & 1) * 32 + (swz % 64) / 2; }
__host__ __device__ __forceinline__ int perm32(int rho) { const int n = rho >> 4, i = rho & 15; return 8 * (i >> 2) + 4 * n + (i & 3); }

struct Unit { int pm, pn; };
struct Gemm { const bf16_t* A; const bf16_t* Bt; int M, N, K, lda, ldb; };

struct StaticOrder {
    int nM, nN, nwg, G, c;
    __host__ __device__ void init(int M, int N, int G_, int c_) { nM = M / BM; nN = N / BM; nwg = nM * nN; G = G_; c = c_; }
    __host__ __device__ bool next(int i, Unit& u) const {
        const long L = (long)i * G + c; if (L >= nwg) return false;
        int wgid = (int)L; { const int q = nwg / NXCD, r = nwg % NXCD, xcd = wgid % NXCD, off = wgid / NXCD; wgid = (xcd < r ? xcd * (q + 1) : r * (q + 1) + (xcd - r) * q) + off; }
        const int nig = WGM * nN, gid = wgid / nig, fm = gid * WGM, gsz = (nM - fm) < WGM ? (nM - fm) : WGM;
        u.pm = fm + ((wgid % nig) % gsz); u.pn = (wgid % nig) / gsz; return true;
    }
    __device__ __forceinline__ void a_ready(const Unit&) const {}
    __device__ __forceinline__ void done(const Unit&) const {}
};

__device__ __forceinline__ unsigned cvt_pk_bf16(float lo, float hi) { unsigned r; asm volatile("v_cvt_pk_bf16_f32 %0, %1, %2" : "=v"(r) : "v"(lo), "v"(hi)); return r; }
template <class Epi, class Sched, bool ALIGN_EPI = false, bool SP2 = false>
__device__ __forceinline__ void gemm_phase(PG8_LAS unsigned char* lds, const Gemm g, const Sched& S, const Epi& E) {
    const int tid = threadIdx.x, wid = __builtin_amdgcn_readfirstlane(tid >> 6), lane = tid & 63, wr = wid >> 2, wc = wid & 3, fr = lane & 15, fq = lane >> 4;
    const int K = g.K, nt = K / BK;
    unsigned voffA[2], voffB[2];
#pragma unroll
    for (int i = 0; i < 2; ++i) { int R, C; stage_rc(tid * 16 + i * 8192, R, C); const int Rb = Epi::PERM ? ((R & ~31) + perm32(R & 31)) : R;
        voffA[i] = (unsigned)(R * g.lda + C) * 2u; voffB[i] = (unsigned)(Rb * g.ldb + C) * 2u; }
    const size_t kstep = (size_t)(BK * 2);
    const size_t hstepA = (size_t)HALF * g.lda * 2, hstepB = (size_t)HALF * g.ldb * 2;
    const size_t tstepA = 2 * hstepA, tstepB = 2 * hstepB;
    const unsigned ldsw = (unsigned)wid * 1024u;
    const int aoff = lds_byte(wr * 64 + fr, fq * 8), boff = lds_byte(wc * 32 + fr, fq * 8);
#define PG8_SA(b, h) (((b) * 2 + (h)) * HTB)
#define PG8_SB(b, h) ((4 + (b) * 2 + (h)) * HTB)
#define PG8_STAGE(bufoff, gbase, voff) do { _Pragma("unroll") for (int _i = 0; _i < 2; ++_i) \
        __builtin_amdgcn_global_load_lds((const unsigned*)((const char*)(gbase) + (voff)[_i]), (PG8_LAS unsigned*)(lds + (bufoff) + ldsw + _i * 8192), 16, 0, 0); } while (0)
#define PG8_LDA(dst, b, h) do { _Pragma("unroll") for (int m = 0; m < 4; ++m) _Pragma("unroll") for (int k = 0; k < 2; ++k) dst[m][k] = *(const PG8_LAS bf16x8*)(lds + PG8_SA(b, h) + aoff + m * 2048 + k * 1024); } while (0)
#define PG8_LDB(dst, b, h) do { _Pragma("unroll") for (int n = 0; n < 2; ++n) _Pragma("unroll") for (int k = 0; k < 2; ++k) dst[n][k] = *(const PG8_LAS bf16x8*)(lds + PG8_SB(b, h) + boff + n * 2048 + k * 1024); } while (0)
#define PG8_MMA(ai, bj, At, Bt) do { __builtin_amdgcn_s_setprio(1); _Pragma("unroll") for (int m = 0; m < 4; ++m) _Pragma("unroll") for (int n = 0; n < 2; ++n) _Pragma("unroll") for (int k = 0; k < 2; ++k) \
        acc[ai][bj][m][n] = __builtin_amdgcn_mfma_f32_16x16x32_bf16(Bt[n][k], At[m][k], acc[ai][bj][m][n], 0, 0, 0); __builtin_amdgcn_s_setprio(0); } while (0)
#define PG8_WAIT_V(n) asm volatile("s_waitcnt vmcnt(" #n ")" ::: "memory")
#define PG8_WAIT_L(n) asm volatile("s_waitcnt lgkmcnt(" #n ")" ::: "memory")
#define PG8_BAR __builtin_amdgcn_s_barrier()
#define PG8_SCHED __builtin_amdgcn_sched_barrier(0)
    Unit cur, nxt; int ui = 0;
    if (!S.next(0, cur)) return;
    f32x4 acc[2][2][4][2];
#pragma unroll
    for (int a = 0; a < 2; ++a)
#pragma unroll
        for (int b = 0; b < 2; ++b)
#pragma unroll
            for (int m = 0; m < 4; ++m)
#pragma unroll
                for (int n = 0; n < 2; ++n) acc[a][b][m][n] = (f32x4){0.f, 0.f, 0.f, 0.f};
    bf16x8 At[4][2], B0[2][2], B1[2][2];
    const char* cA = (const char*)g.A + (size_t)cur.pm * tstepA; const char* cB = (const char*)g.Bt + (size_t)cur.pn * tstepB;
    S.a_ready(cur);
    if constexpr (SP2) {
        PG8_STAGE(PG8_SB(0, 0), cB, voffB); PG8_STAGE(PG8_SB(0, 1), cB + hstepB, voffB); PG8_STAGE(PG8_SA(0, 0), cA, voffA); PG8_STAGE(PG8_SA(0, 1), cA + hstepA, voffA);
        if (wr == 1) PG8_BAR;
        PG8_WAIT_V(2); PG8_BAR;
        PG8_STAGE(PG8_SB(1, 0), cB + kstep, voffB); PG8_STAGE(PG8_SA(1, 0), cA + kstep, voffA); PG8_STAGE(PG8_SB(1, 1), cB + hstepB + kstep, voffB);
        PG8_WAIT_V(6); PG8_BAR;
    } else {
        PG8_STAGE(PG8_SB(0, 0), cB, voffB); PG8_STAGE(PG8_SA(0, 0), cA, voffA); PG8_STAGE(PG8_SB(0, 1), cB + hstepB, voffB); PG8_STAGE(PG8_SA(0, 1), cA + hstepA, voffA);
        if (wr == 1) PG8_BAR;
        PG8_WAIT_V(4); PG8_BAR;
        PG8_STAGE(PG8_SB(1, 0), cB + kstep, voffB); PG8_STAGE(PG8_SA(1, 0), cA + kstep, voffA); PG8_STAGE(PG8_SB(1, 1), cB + hstepB + kstep, voffB);
        PG8_WAIT_V(6); PG8_BAR;
    }
    for (;;) {
        const bool has_next = S.next(ui + 1, nxt);
        const char* nA = has_next ? (const char*)g.A + (size_t)nxt.pm * tstepA : cA; const char* nB = has_next ? (const char*)g.Bt + (size_t)nxt.pn * tstepB : cB;
        for (int t = 0; t < nt; t += 2) {
            const bool last = (t == nt - 2);
            const char* a1 = cA + (size_t)(t + 1) * kstep;
            const char* a2 = last ? nA : cA + (size_t)(t + 2) * kstep; const char* b2 = last ? nB : cB + (size_t)(t + 2) * kstep;
            const char* a3 = a2 + kstep; const char* b3 = b2 + kstep;
            if (last && has_next) S.a_ready(nxt);
            if constexpr (SP2) {
            PG8_LDB(B0, 0, 0); PG8_LDB(B1, 0, 1); PG8_SCHED; PG8_LDA(At, 0, 0); PG8_STAGE(PG8_SA(1, 1), a1 + hstepA, voffA);
            PG8_WAIT_V(8); PG8_WAIT_L(0); PG8_BAR; PG8_MMA(0, 0, At, B0); PG8_MMA(0, 1, At, B1); PG8_BAR; PG8_SCHED;
            PG8_LDA(At, 0, 1); PG8_STAGE(PG8_SB(0, 0), b2, voffB); PG8_STAGE(PG8_SB(0, 1), b2 + hstepB, voffB); PG8_STAGE(PG8_SA(0, 0), a2, voffA);
            PG8_WAIT_V(8); PG8_WAIT_L(0); PG8_BAR; PG8_MMA(1, 0, At, B0); PG8_MMA(1, 1, At, B1); PG8_BAR; PG8_SCHED;
            PG8_LDB(B0, 1, 0); PG8_LDB(B1, 1, 1); PG8_SCHED; PG8_LDA(At, 1, 0); PG8_STAGE(PG8_SA(0, 1), a2 + hstepA, voffA);
            PG8_WAIT_V(8); PG8_WAIT_L(0); PG8_BAR; PG8_MMA(0, 0, At, B0); PG8_MMA(0, 1, At, B1); PG8_BAR; PG8_SCHED;
            PG8_LDA(At, 1, 1); PG8_STAGE(PG8_SB(1, 0), b3, voffB); PG8_STAGE(PG8_SB(1, 1), b3 + hstepB, voffB); PG8_STAGE(PG8_SA(1, 0), a3, voffA);
            PG8_WAIT_V(8); PG8_WAIT_L(0); PG8_BAR; PG8_MMA(1, 0, At, B0); PG8_MMA(1, 1, At, B1); PG8_BAR; PG8_SCHED;
            } else {
            PG8_LDB(B0, 0, 0); PG8_SCHED; PG8_LDA(At, 0, 0); PG8_STAGE(PG8_SA(1, 1), a1 + hstepA, voffA);
            PG8_WAIT_L(8); PG8_BAR; PG8_WAIT_L(0); PG8_MMA(0, 0, At, B0); PG8_BAR; PG8_SCHED;
            PG8_LDB(B1, 0, 1); PG8_STAGE(PG8_SB(0, 0), b2, voffB);
            PG8_BAR; PG8_WAIT_L(0); PG8_MMA(0, 1, At, B1); PG8_BAR;
            PG8_LDA(At, 0, 1); PG8_STAGE(PG8_SA(0, 0), a2, voffA);
            PG8_BAR; PG8_WAIT_L(0); PG8_MMA(1, 0, At, B0); PG8_BAR; PG8_SCHED;
            PG8_STAGE(PG8_SB(0, 1), b2 + hstepB, voffB);
            PG8_WAIT_V(6); PG8_BAR; PG8_MMA(1, 1, At, B1); PG8_BAR;
            PG8_LDB(B0, 1, 0); PG8_SCHED; PG8_LDA(At, 1, 0); PG8_STAGE(PG8_SA(0, 1), a2 + hstepA, voffA);
            PG8_WAIT_L(8); PG8_BAR; PG8_WAIT_L(0); PG8_MMA(0, 0, At, B0); PG8_BAR; PG8_SCHED;
            PG8_LDB(B1, 1, 1); PG8_STAGE(PG8_SB(1, 0), b3, voffB);
            PG8_BAR; PG8_WAIT_L(0); PG8_MMA(0, 1, At, B1); PG8_BAR;
            PG8_LDA(At, 1, 1); PG8_STAGE(PG8_SA(1, 0), a3, voffA);
            PG8_BAR; PG8_WAIT_L(0); PG8_MMA(1, 0, At, B0); PG8_BAR; PG8_SCHED;
            PG8_STAGE(PG8_SB(1, 1), b3 + hstepB, voffB);
            PG8_WAIT_V(6); PG8_BAR; PG8_MMA(1, 1, At, B1); PG8_BAR;
            }
        }
        if constexpr (ALIGN_EPI) { if (wr == 0) PG8_BAR; }
        if constexpr (!Epi::AFTER_DRAIN) { E(acc, cur, wr, wc, fr, fq); S.done(cur); }
        if (!has_next) break;
#pragma unroll
        for (int a = 0; a < 2; ++a)
#pragma unroll
            for (int b = 0; b < 2; ++b)
#pragma unroll
                for (int m = 0; m < 4; ++m)
#pragma unroll
                    for (int n = 0; n < 2; ++n) acc[a][b][m][n] = (f32x4){0.f, 0.f, 0.f, 0.f};
        cur = nxt; cA = nA; cB = nB; ++ui;
        if constexpr (ALIGN_EPI) { if (wr == 1) PG8_BAR; }
    }
    PG8_WAIT_V(0);
    if constexpr (!ALIGN_EPI) { if (wr == 0) PG8_BAR; }
    PG8_BAR;
    if constexpr (Epi::AFTER_DRAIN) { E.fused(acc, cur, wr, wc, fr, fq, lds, wid, lane); S.done(cur); }
#undef PG8_SA
#undef PG8_SB
#undef PG8_STAGE
#undef PG8_LDA
#undef PG8_LDB
#undef PG8_MMA
#undef PG8_WAIT_V
#undef PG8_WAIT_L
#undef PG8_BAR
#undef PG8_SCHED
}
}
#define DBG_SOLVE 0
#define NPHASE_STEPS 11
#define PROGRAM_STEPS STEP(0, 0) STEP(1, 1) STEP(2, 2) STEP(3, 3) STEP(4, 4) STEP(5, 5) STEP(6, 6) STEP(7, 7) STEP(8, 8) STEP(9, 10) STEP(10, 11)
typedef unsigned short bf16;
typedef short bf16x8 __attribute__((ext_vector_type(8)));
typedef short bf16x4 __attribute__((ext_vector_type(4)));
typedef float f32x4 __attribute__((ext_vector_type(4)));
typedef float f32x2 __attribute__((ext_vector_type(2)));
typedef unsigned u32x4 __attribute__((ext_vector_type(4)));
typedef unsigned u32x2 __attribute__((ext_vector_type(2)));

constexpr int NB = 4, T = 4096, D = 1024, M = NB * T, H = 8, CH = 128, NCH = T / CH;
constexpr int DFF = 2816, NUP = 2 * DFF;
constexpr int N1 = 5120, N5 = 4096, NIN = 9216, DIN = 9232;
constexpr float EPS = 1e-6f, GN_EPS = 1e-5f;
constexpr size_t MiB = 1u << 20;
constexpr size_t WS_CTL = 0, CTL_BYTES = 16384;
constexpr size_t WS_R1 = MiB / 4, WS_GB = MiB / 2, WS_SS1 = 3 * MiB / 2, WS_SS2 = 5 * MiB / 2, WS_ROPE = 7 * MiB / 2, WS_GC = 9 * MiB / 2, WS_HALO = 5 * MiB;
constexpr size_t WS_WIN = 8 * MiB;
constexpr size_t WS_KV = 16 * MiB, WS_UX = 32 * MiB, WS_H1B = 32 * MiB;
constexpr size_t WS_RQ = 64 * MiB, WS_RK = 80 * MiB, WS_RV = 96 * MiB, WS_DQ = 128 * MiB, WS_DK = 160 * MiB, WS_DV = 192 * MiB;
constexpr size_t WS_SN = 224 * MiB;
constexpr size_t WS_WRET = 224 * MiB, WS_WDN = 226 * MiB, WS_WO = 228 * MiB, WS_WUP = 230 * MiB, WS_WDOWN = 241 * MiB;
constexpr size_t WS_ACT = 64 * MiB, WS_HBUF = 152 * MiB, WS_END = 256 * MiB;
constexpr size_t OUT_W = 0, OUT_KDT = 32 * MiB;
constexpr int LDS_BYTES = 147456;
#ifndef NPHASE_STEPS
#define NPHASE_STEPS 11
#endif
constexpr int NPHASE = NPHASE_STEPS;

#ifndef N_LAUNCH_MODE
#define N_LAUNCH_MODE 1
#endif

typedef __bf16 bf16x2n __attribute__((ext_vector_type(2)));
__device__ __forceinline__ unsigned pk2(float lo, float hi) { const f32x2 f = {lo, hi}; return __builtin_bit_cast(unsigned, __builtin_convertvector(f, bf16x2n)); }
__device__ __forceinline__ float bflo(unsigned u) { return __uint_as_float(u << 16); }
__device__ __forceinline__ float bfhi(unsigned u) { return __uint_as_float(u & 0xffff0000u); }
__device__ __forceinline__ float bf2f(bf16 h) { return __uint_as_float(((unsigned)h) << 16); }
__device__ __forceinline__ bf16 f2bf(float f) { return (bf16)(pk2(f, 0.f) & 0xffffu); }
__device__ __forceinline__ float silu_f(float x) { return x * __builtin_amdgcn_rcpf(1.f + __expf(-x)); }
__device__ __forceinline__ float sigm_f(float x) { return __builtin_amdgcn_rcpf(1.f + __expf(-x)); }
__device__ __forceinline__ f32x4 mfma32(bf16x8 a, bf16x8 b, f32x4 c) { return __builtin_amdgcn_mfma_f32_16x16x32_bf16(a, b, c, 0, 0, 0); }
__device__ __forceinline__ f32x4 mfma16(bf16x4 a, bf16x4 b, f32x4 c) { return __builtin_amdgcn_mfma_f32_16x16x16bf16_1k(a, b, c, 0, 0, 0); }
__device__ __forceinline__ bf16x4 pack4(f32x4 v) { u32x2 w; w.x = pk2(v[0], v[1]); w.y = pk2(v[2], v[3]); return __builtin_bit_cast(bf16x4, w); }
__device__ __forceinline__ u32x4 pack8(f32x4 a, f32x4 b) { u32x4 w; w.x = pk2(a[0], a[1]); w.y = pk2(a[2], a[3]); w.z = pk2(b[0], b[1]); w.w = pk2(b[2], b[3]); return w; }
__device__ __forceinline__ void unpack8(u32x4 w, f32x4& a, f32x4& b) { a = (f32x4){bflo(w.x), bfhi(w.x), bflo(w.y), bfhi(w.y)}; b = (f32x4){bflo(w.z), bfhi(w.z), bflo(w.w), bfhi(w.w)}; }
#define LDSWAIT() asm volatile("s_waitcnt lgkmcnt(0)" ::: "memory")

struct Ctx {
    const float *x, *g_mix, *w_in, *ret_norm_g, *dn_conv_w, *dn_a_log, *dn_dt_bias, *dn_norm_g, *w_ret_br, *w_dn_br, *w_o, *g_ffn, *w_up, *ffn_conv_w, *ffn_conv_b, *w_down, *g_final;
    float* out; unsigned char* ws; unsigned char* lds;
    int tid, lane, wave, bid, G, fr, fq;
};

template <class F> struct EpiRow8 {
    static constexpr bool PERM = true, AFTER_DRAIN = false; F f;
    __device__ __forceinline__ void operator()(const pg8::f32x4 (&acc)[2][2][4][2], const pg8::Unit& u, int wr, int wc, int fr, int fq) const {
#pragma unroll
        for (int ai = 0; ai < 2; ++ai)
#pragma unroll
            for (int m = 0; m < 4; ++m) { const int row = u.pm * 256 + ai * 128 + wr * 64 + m * 16 + fr;
#pragma unroll
                for (int bj = 0; bj < 2; ++bj) { const int col = u.pn * 256 + bj * 128 + wc * 32 + 8 * fq; f(row, col, acc[ai][bj][m][0], acc[ai][bj][m][1]); } }
    }
};

struct F1 {
    const float* r1; const float* rope; bf16 *rq, *rk, *rv, *dqkv, *halo;
    __device__ __forceinline__ void operator()(int row, int col, f32x4 v0, f32x4 v1) const {
        const float r = r1[row]; v0 = v0 * r; v1 = v1 * r;
        if (col < 1024) {
            const int t = row & (T - 1), p0 = (col & 63) >> 1;
            const f32x4 cs0 = *(const f32x4*)(rope + ((size_t)t * 32 + p0) * 2), cs1 = *(const f32x4*)(rope + ((size_t)t * 32 + p0) * 2 + 4);
            const float sc = col >= 512 ? 0.125f : 1.f;
            f32x4 o0, o1;
            o0[0] = (v0[0] * cs0[0] - v0[1] * cs0[1]) * sc; o0[1] = (v0[0] * cs0[1] + v0[1] * cs0[0]) * sc;
            o0[2] = (v0[2] * cs0[2] - v0[3] * cs0[3]) * sc; o0[3] = (v0[2] * cs0[3] + v0[3] * cs0[2]) * sc;
            o1[0] = (v1[0] * cs1[0] - v1[1] * cs1[1]) * sc; o1[1] = (v1[0] * cs1[1] + v1[1] * cs1[0]) * sc;
            o1[2] = (v1[2] * cs1[2] - v1[3] * cs1[3]) * sc; o1[3] = (v1[2] * cs1[3] + v1[3] * cs1[2]) * sc;
            bf16* dst = (col < 512 ? rq : rk) + (size_t)row * 512 + (col & 511);
            *(u32x4*)dst = pack8(o0, o1);
        } else if (col < 2048) {
            *(u32x4*)(rv + (size_t)row * 1024 + (col - 1024)) = pack8(v0, v1);
        } else {
            const int cc = col - 2048; const u32x4 w = pack8(v0, v1);
            *(u32x4*)(dqkv + (size_t)(cc >> 10) * ((size_t)M * 1024) + (size_t)row * 1024 + (cc & 1023)) = w;
            if ((row & 127) >= 125) *(u32x4*)(halo + ((size_t)(row >> 7) * 3 + ((row & 127) - 125)) * 3072 + cc) = w;
        }
    }
};
struct F5 {
    const float* r1; bf16 *rv, *dv, *sigr, *sigd;
    __device__ __forceinline__ void operator()(int row, int col, f32x4 v0, f32x4 v1) const {
        const float r = r1[row]; v0 = v0 * r; v1 = v1 * r;
        const int t = col >> 10, cc = col & 1023;
        if (t < 2) {
            bf16* p = (t == 0 ? rv : dv) + (size_t)row * 1024 + cc; f32x4 a, b; unpack8(*(const u32x4*)p, a, b);
#pragma unroll
            for (int e = 0; e < 4; ++e) { a[e] *= silu_f(v0[e]); b[e] *= silu_f(v1[e]); }
            *(u32x4*)p = pack8(a, b);
        } else {
            bf16* p = (t == 2 ? sigr : sigd) + (size_t)row * 1024 + cc; f32x4 a, b;
#pragma unroll
            for (int e = 0; e < 4; ++e) { a[e] = sigm_f(v0[e]); b[e] = sigm_f(v1[e]); }
            *(u32x4*)p = pack8(a, b);
        }
    }
};
struct F6a { bf16* sigr;
    __device__ __forceinline__ void operator()(int row, int col, f32x4 v0, f32x4 v1) const {
        bf16* p = sigr + (size_t)row * 1024 + col; f32x4 a, b; unpack8(*(const u32x4*)p, a, b); a = a * v0; b = b * v1; *(u32x4*)p = pack8(a, b); }
};
struct F6b { bf16* sigr; const bf16* sigd;
    __device__ __forceinline__ void operator()(int row, int col, f32x4 v0, f32x4 v1) const {
        bf16* p = sigr + (size_t)row * 1024 + col; f32x4 a, b, s0, s1; unpack8(*(const u32x4*)p, a, b); unpack8(*(const u32x4*)(sigd + (size_t)row * 1024 + col), s0, s1);
        a = a + s0 * v0; b = b + s1 * v1; *(u32x4*)p = pack8(a, b); }
};
template <bool BASE_F32> struct EpiRes {
    static constexpr bool PERM = true, AFTER_DRAIN = false;
    const float* basef; bf16* hb; float* ss;
    __device__ __forceinline__ void operator()(const pg8::f32x4 (&acc)[2][2][4][2], const pg8::Unit& u, int wr, int wc, int fr, int fq) const {
#pragma unroll
        for (int ai = 0; ai < 2; ++ai)
#pragma unroll
            for (int m = 0; m < 4; ++m) { const int row = u.pm * 256 + ai * 128 + wr * 64 + m * 16 + fr; float ssq = 0.f;
#pragma unroll
                for (int bj = 0; bj < 2; ++bj) { const int col = u.pn * 256 + bj * 128 + wc * 32 + 8 * fq; const size_t off = (size_t)row * 1024 + col;
                    f32x4 b0, b1;
                    if (BASE_F32) { b0 = *(const f32x4*)(basef + off); b1 = *(const f32x4*)(basef + off + 4); } else unpack8(*(const u32x4*)(hb + off), b0, b1);
                    const f32x4 h0 = b0 + acc[ai][bj][m][0], h1 = b1 + acc[ai][bj][m][1];
                    *(u32x4*)(hb + off) = pack8(h0, h1);
                    ssq += (h0[0] * h0[0] + h0[1] * h0[1]) + (h0[2] * h0[2] + h0[3] * h0[3]) + (h1[0] * h1[0] + h1[1] * h1[1]) + (h1[2] * h1[2] + h1[3] * h1[3]); }
                ssq += __shfl_xor(ssq, 16); ssq += __shfl_xor(ssq, 32);
                if (fq == 0) ss[(size_t)row * 16 + u.pn * 4 + wc] = ssq; }
    }
};
__device__ __forceinline__ float dpp_ror1(float v) { return __builtin_bit_cast(float, __builtin_amdgcn_mov_dpp(__builtin_bit_cast(int, v), 0x121, 0xf, 0xf, false)); }
__device__ __forceinline__ float dpp_ror2(float v) { return __builtin_bit_cast(float, __builtin_amdgcn_mov_dpp(__builtin_bit_cast(int, v), 0x122, 0xf, 0xf, false)); }
struct Epi8 {
    static constexpr bool PERM = true, AFTER_DRAIN = false;
    const float* ss; bf16 *act, *hbuf; const float *cw, *cb;
    __device__ __forceinline__ void operator()(const pg8::f32x4 (&acc)[2][2][4][2], const pg8::Unit& u, int wr, int wc, int fr, int fq) const {
#pragma unroll
        for (int bj = 0; bj < 2; ++bj) {
            const int col = u.pn * 256 + bj * 128 + wc * 32 + 8 * fq, j0 = col >> 1;
            f32x4 W0[3], W1[3], B0, B1;
            { f32x4 wa[3], wb[3];
#pragma unroll
              for (int k = 0; k < 3; ++k) { wa[k] = *(const f32x4*)(cw + (size_t)k * NUP + j0); wb[k] = *(const f32x4*)(cw + (size_t)k * NUP + DFF + j0);
                  W0[k] = (f32x4){wa[k][0], wb[k][0], wa[k][1], wb[k][1]}; W1[k] = (f32x4){wa[k][2], wb[k][2], wa[k][3], wb[k][3]}; }
              const f32x4 ba = *(const f32x4*)(cb + j0), bb = *(const f32x4*)(cb + DFF + j0);
              B0 = (f32x4){ba[0], bb[0], ba[1], bb[1]}; B1 = (f32x4){ba[2], bb[2], ba[3], bb[3]}; }
#pragma unroll
            for (int ai = 0; ai < 2; ++ai) {
                f32x4 pv0 = (f32x4){0.f, 0.f, 0.f, 0.f}, pv1 = pv0;
#pragma unroll
                for (int m = 0; m < 4; ++m) {
                    const int row = u.pm * 256 + ai * 128 + wr * 64 + m * 16 + fr;
                    const f32x4* sp = (const f32x4*)(ss + (size_t)row * 16); const f32x4 s4 = (sp[0] + sp[1]) + (sp[2] + sp[3]);
                    const float rr = rsqrtf(((s4[0] + s4[1]) + (s4[2] + s4[3])) * (1.f / 1024.f) + EPS);
                    const f32x4 c0 = acc[ai][bj][m][0] * rr, c1 = acc[ai][bj][m][1] * rr;
                    f32x4 p10, p11, p20, p21;
#pragma unroll
                    for (int e = 0; e < 4; ++e) {
                        p10[e] = dpp_ror1(fr == 15 ? pv0[e] : c0[e]); p11[e] = dpp_ror1(fr == 15 ? pv1[e] : c1[e]);
                        p20[e] = dpp_ror2(fr >= 14 ? pv0[e] : c0[e]); p21[e] = dpp_ror2(fr >= 14 ? pv1[e] : c1[e]); }
                    const f32x4 y0 = W0[0] * p20 + W0[1] * p10 + W0[2] * c0 + B0, y1 = W1[0] * p21 + W1[1] * p11 + W1[2] * c1 + B1;
                    const f32x4 o = (f32x4){silu_f(y0[0]) * y0[1], silu_f(y0[2]) * y0[3], silu_f(y1[0]) * y1[1], silu_f(y1[2]) * y1[3]};
                    const bool head = (m == 0) && (fr < 2);
                    if (!head) *(bf16x4*)(act + (size_t)row * DFF + j0) = pack4(o);
                    if (head || (m == 3 && fr >= 14)) { const int slot = (m == 0) ? fr : (fr - 12);
                        *(u32x4*)(hbuf + ((size_t)(row >> 6) * 4 + slot) * NUP + col) = pack8(c0, c1); }
                    pv0 = c0; pv1 = c1;
                    asm volatile("" ::: "memory");
                }
            }
        }
    }
};

__device__ __forceinline__ int win_srccol_old(int n) {
    if (n < 1024) return (n & ~63) + ((n & 63) >> 1) + 32 * (n & 1);
    if (n < 2048) return n;
    if (n < 5120) return n + 1024;
    if (n < 6144) return n - 5120 + 2048;
    if (n < 7168) return n;
    return n + 16;
}
__device__ __forceinline__ int win_srccol(int n) { return win_srccol_old(n < N5 ? n + N1 : n - N5); }
template <int MAP> __device__ __forceinline__ void transpose_item(const float* W, int K, int N, bf16* WT, const float* gk, float* scr, int item, int nblk, int lane) {
    const int kb = item / nblk, nb = item % nblk, k0 = 64 * kb, n0 = 32 * nb;
    const int ng = lane & 7, kr = lane >> 3, np = n0 + 4 * ng;
    bool pair = false; int s0 = np, s1 = 0;
    if (MAP == 2) { pair = true; s0 = np >> 1; s1 = s0 + DFF; }
    if (MAP == 1) { const int o = np < N5 ? np + N1 : np - N5; if (o < 1024) { pair = true; s0 = (o & ~63) + ((o & 63) >> 1); s1 = s0 + 32; } else s0 = win_srccol_old(o); }
#pragma unroll
    for (int i = 0; i < 8; ++i) { const int kk = 8 * i + kr; const float* row = W + (size_t)(k0 + kk) * N; f32x4 v;
        if (pair) { const f32x2 p0 = *(const f32x2*)(row + s0), p1 = *(const f32x2*)(row + s1); v = (f32x4){p0[0], p1[0], p0[1], p1[1]}; }
        else v = *(const f32x4*)(row + s0);
        if (gk) v = v * gk[k0 + kk];
        float* d = scr + kk * 33 + 4 * ng; d[0] = v[0]; d[1] = v[1]; d[2] = v[2]; d[3] = v[3]; }
    LDSWAIT();
    const int c = lane & 7;
#pragma unroll
    for (int j = 0; j < 4; ++j) { const int n = (lane >> 3) + 8 * j; const float* s = scr + (8 * c) * 33 + n;
        u32x4 o; o.x = pk2(s[0 * 33], s[1 * 33]); o.y = pk2(s[2 * 33], s[3 * 33]); o.z = pk2(s[4 * 33], s[5 * 33]); o.w = pk2(s[6 * 33], s[7 * 33]);
        *(u32x4*)(WT + (size_t)(n0 + n) * K + k0 + 8 * c) = o; }
    LDSWAIT();
}
__device__ __forceinline__ void phase0(const Ctx& c) {
    float* scr = (float*)(c.lds + c.wave * 16384);
    const int gw = c.bid * 8 + c.wave, ngw = c.G * 8;
    constexpr int I_IN = 16 * (NIN / 32);
    for (int it = gw; it < I_IN; it += ngw) transpose_item<1>(c.w_in, 1024, DIN, (bf16*)(c.ws + WS_WIN), nullptr, scr, it, NIN / 32, c.lane);
    float* rope = (float*)(c.ws + WS_ROPE);
    for (int i = c.bid * 512 + c.tid; i < T * 32; i += c.G * 512) { const int t = i >> 5, p = i & 31;
        const float inv = exp2f(-(float)p * 0.41524101186092029f); const float ang = (float)t * inv;
        const double rev = (double)ang * 0.15915494309189535; const float fr_ = (float)(rev - rint(rev));
        rope[2 * i] = __cosf(fr_ * 6.283185307179586f); rope[2 * i + 1] = __sinf(fr_ * 6.283185307179586f); }
    __syncthreads();
    bf16* wab = (bf16*)c.lds;
    for (int i = c.tid; i < 16 * 1024; i += 512) { const int n = i & 15, k = i >> 4; wab[n * 1032 + k] = f2bf(c.w_in[(size_t)k * DIN + 7168 + n]); }
    __syncthreads();
    bf16* Ux = (bf16*)(c.ws + WS_UX); float* r1 = (float*)(c.ws + WS_R1); float* gb = (float*)(c.ws + WS_GB);
    const int fr = c.fr, fq = c.fq;
    if ((c.wave & 1) == 0) for (int gi = c.bid * 4 + (c.wave >> 1); gi < M / 16; gi += c.G * 4) {
        const int row0 = gi * 16; const float* xr = c.x + (size_t)(row0 + fr) * 1024 + 8 * fq; bf16* ur = Ux + (size_t)(row0 + fr) * 1024 + 8 * fq;
        f32x4 acc = (f32x4){0.f, 0.f, 0.f, 0.f}; float ssq = 0.f;
#pragma unroll 4
        for (int kk = 0; kk < 32; ++kk) {
            f32x4 a0 = *(const f32x4*)(xr + 32 * kk), a1 = *(const f32x4*)(xr + 32 * kk + 4);
            const f32x4 g0 = *(const f32x4*)(c.g_mix + 32 * kk + 8 * fq), g1 = *(const f32x4*)(c.g_mix + 32 * kk + 8 * fq + 4);
            ssq += (a0[0] * a0[0] + a0[1] * a0[1]) + (a0[2] * a0[2] + a0[3] * a0[3]) + (a1[0] * a1[0] + a1[1] * a1[1]) + (a1[2] * a1[2] + a1[3] * a1[3]);
            a0 = a0 * g0; a1 = a1 * g1; const u32x4 pk = pack8(a0, a1);
            *(u32x4*)(ur + 32 * kk) = pk;
            const bf16x8 bfr = *(const bf16x8*)(wab + fr * 1032 + 32 * kk + 8 * fq);
            acc = mfma32(__builtin_bit_cast(bf16x8, pk), bfr, acc);
        }
        ssq += __shfl_xor(ssq, 16); ssq += __shfl_xor(ssq, 32);
        const float r = rsqrtf(ssq * (1.f / 1024.f) + EPS);
        if (fq == 0) r1[row0 + fr] = r;
#pragma unroll
        for (int j = 0; j < 4; ++j) { const float rj = __shfl(r, 4 * fq + j); const float val = acc[j] * rj; const int row = row0 + 4 * fq + j; float o;
            if (fr < 8) o = sigm_f(val);
            else { const int hh = fr - 8; const float z = val + c.dn_dt_bias[hh]; const float sp = z > 20.f ? z : log1pf(expf(z)); o = -expf(c.dn_a_log[hh]) * sp; }
            gb[(size_t)row * 16 + fr] = o; }
    }
}

constexpr int L_KS = 0, L_KT = 34816, L_VT = 68608, L_AB = 102400, L_TII = 137216, L_G = 141312;
__device__ __forceinline__ void dn_prep(const Ctx& c, int id) {
    const int bh = id >> 5, n = id & 31, b = bh >> 3, h = bh & 7, rowbase = b * T + n * CH;
    const int tid = c.tid, fr = c.fr, fq = c.fq, w = c.wave;
    bf16* ks = (bf16*)(c.lds + L_KS); bf16* kT = (bf16*)(c.lds + L_KT); bf16* vT = (bf16*)(c.lds + L_VT); bf16* Ab = (bf16*)(c.lds + L_AB); bf16* Tii = (bf16*)(c.lds + L_TII);
    float* Gs = (float*)(c.lds + L_G); float* Bs = Gs + 128; float* graw = Gs + 256;
    const float* gb = (const float*)(c.ws + WS_GB); float* Gc = (float*)(c.ws + WS_GC);
    bf16* dqkv = (bf16*)(c.ws + WS_DQ); const bf16* halo = (const bf16*)(c.ws + WS_HALO);
    if (tid < 128) { graw[tid] = gb[(size_t)(rowbase + tid) * 16 + 8 + h]; Bs[tid] = gb[(size_t)(rowbase + tid) * 16 + h]; }
    __syncthreads();
    if (tid < 128) {
        float s = graw[tid];
#pragma unroll
        for (int o = 1; o < 64; o <<= 1) { const float t = __shfl_up(s, o); if (c.lane >= o) s += t; }
        if (tid >= 64) { float tot = 0.f;
#pragma unroll 8
            for (int t = 0; t < 64; t += 4) { const f32x4 g4 = *(const f32x4*)(graw + t); tot += (g4[0] + g4[1]) + (g4[2] + g4[3]); }
            s += tot; }
        Gs[tid] = s; Gc[(size_t)id * 128 + tid] = s; }
    const int i = tid >> 2, cg = tid & 3;
    bf16* qs = Ab;
#ifndef DP_SKIP_CONV
    {
        const int cgp = tid & 15, strip = tid >> 4, col8 = 8 * cgp, i4 = 4 * strip;
#pragma unroll 1
        for (int t = 1; t < 3; ++t) {
            u32x4 raw[7];
#pragma unroll
            for (int k = 0; k < 7; ++k) { const int rr = i4 - 3 + k; u32x4 r = (u32x4){0u, 0u, 0u, 0u};
                if (rr >= 0) r = *(const u32x4*)(dqkv + (size_t)t * ((size_t)M * 1024) + (size_t)(rowbase + rr) * 1024 + h * 128 + col8);
                else if (n > 0) r = *(const u32x4*)(halo + ((size_t)(b * 32 + n - 1) * 3 + (rr + 3)) * 3072 + t * 1024 + h * 128 + col8);
                raw[k] = r; }
            f32x4 w0[4], w1[4];
#pragma unroll
            for (int k = 0; k < 4; ++k) { const float* wp = c.dn_conv_w + (size_t)k * 3072 + t * 1024 + h * 128 + col8; w0[k] = *(const f32x4*)wp; w1[k] = *(const f32x4*)(wp + 4); }
            f32x4 y0[4], y1[4]; float ssq[4];
#pragma unroll
            for (int r = 0; r < 4; ++r) { f32x4 a0 = (f32x4){0.f, 0.f, 0.f, 0.f}, a1 = a0;
#pragma unroll
                for (int k = 0; k < 4; ++k) { f32x4 x0, x1; unpack8(raw[r + k], x0, x1); a0 = a0 + x0 * w0[k]; a1 = a1 + x1 * w1[k]; }
                float sq = 0.f;
#pragma unroll
                for (int e = 0; e < 4; ++e) { a0[e] = silu_f(a0[e]); a1[e] = silu_f(a1[e]); sq += a0[e] * a0[e] + a1[e] * a1[e]; }
                y0[r] = a0; y1[r] = a1; ssq[r] = sq; }
            if (t < 2) {
#pragma unroll
                for (int r = 0; r < 4; ++r) { float sq = ssq[r]; sq += __shfl_xor(sq, 1); sq += __shfl_xor(sq, 2); sq += __shfl_xor(sq, 4); sq += __shfl_xor(sq, 8);
                    const float rn = rsqrtf(sq + EPS); y0[r] = y0[r] * rn; y1[r] = y1[r] * rn; }
            }
            u32x4 p[4];
#pragma unroll
            for (int r = 0; r < 4; ++r) p[r] = pack8(y0[r], y1[r]);
            if (t == 0) {
#pragma unroll
                for (int r = 0; r < 4; ++r) *(u32x4*)(qs + (i4 + r) * 136 + col8) = p[r];
            } else {
                if (t == 1) {
#pragma unroll
                    for (int r = 0; r < 4; ++r) *(u32x4*)(ks + (i4 + r) * 136 + col8) = p[r];
                }
                bf16* dT = (t == 1) ? kT : vT;
                const unsigned pw[4][4] = {{p[0].x, p[0].y, p[0].z, p[0].w}, {p[1].x, p[1].y, p[1].z, p[1].w}, {p[2].x, p[2].y, p[2].z, p[2].w}, {p[3].x, p[3].y, p[3].z, p[3].w}};
#pragma unroll
                for (int e = 0; e < 4; ++e) {
                    u32x2 lo, hi;
                    lo.x = (pw[0][e] & 0xffffu) | (pw[1][e] << 16); lo.y = (pw[2][e] & 0xffffu) | (pw[3][e] << 16);
                    hi.x = (pw[0][e] >> 16) | (pw[1][e] & 0xffff0000u); hi.y = (pw[2][e] >> 16) | (pw[3][e] & 0xffff0000u);
                    *(u32x2*)(dT + (col8 + 2 * e) * 132 + i4) = lo; *(u32x2*)(dT + (col8 + 2 * e + 1) * 132 + i4) = hi;
                }
            }
        }
    }
#endif
    __syncthreads();
#pragma unroll
    for (int s4 = 0; s4 < 4; ++s4) { const int idx = tid + 512 * s4, r = idx >> 4, c8 = (idx & 15) * 8;
        *(u32x4*)(dqkv + (size_t)M * 1024 + (size_t)(rowbase + r) * 1024 + h * 128 + c8) = *(const u32x4*)(ks + r * 136 + c8);
    }
    __syncthreads();
#ifndef DP_SKIP_KK
    {
        const int i0 = 16 * w; bf16x8 ai[4];
#pragma unroll
        for (int kk = 0; kk < 4; ++kk) ai[kk] = *(const bf16x8*)(ks + (i0 + fr) * 136 + 32 * kk + 8 * fq);
        const float Gi = Gs[i0 + fr], bi_ = Bs[i0 + fr];
        for (int jt = 0; jt <= w; ++jt) {
            f32x4 acc = (f32x4){0.f, 0.f, 0.f, 0.f};
#pragma unroll
            for (int kk = 0; kk < 4; ++kk) acc = mfma32(*(const bf16x8*)(ks + (16 * jt + fr) * 136 + 32 * kk + 8 * fq), ai[kk], acc);
            const f32x4 G4 = *(const f32x4*)(Gs + 16 * jt + 4 * fq); f32x4 o;
#pragma unroll
            for (int r = 0; r < 4; ++r) { const int j = 16 * jt + 4 * fq + r; o[r] = (i0 + fr > j) ? -bi_ * acc[r] * __expf(Gi - G4[r]) : 0.f; }
            *(bf16x4*)(Ab + (i0 + fr) * 136 + 16 * jt + 4 * fq) = pack4(o);
        }
    }
#endif
    __syncthreads();
#ifndef DP_SKIP_TII
    if (tid < 128) {
        const int blk = tid >> 4, cx = tid & 15; float xs[16];
#pragma unroll
        for (int r = 0; r < 16; ++r) {
            float s = (r == cx) ? 1.f : 0.f;
            const u32x4 ra = *(const u32x4*)(Ab + (16 * blk + r) * 136 + 16 * blk), rb = *(const u32x4*)(Ab + (16 * blk + r) * 136 + 16 * blk + 8);
            const unsigned rw[8] = {ra.x, ra.y, ra.z, ra.w, rb.x, rb.y, rb.z, rb.w};
#pragma unroll
            for (int s_ = 0; s_ < r; ++s_) { const float av = (s_ & 1) ? bfhi(rw[s_ >> 1]) : bflo(rw[s_ >> 1]); s += av * xs[s_]; }
            xs[r] = s; Tii[(blk * 16 + r) * 16 + cx] = f2bf(s);
            asm volatile("" ::: "memory");
        }
    }
#endif
#ifndef DP_SKIP_KD
    {
        const int d = tid >> 2, ig = tid & 3; const float Gl = Gs[127]; bf16* dst = (bf16*)(c.out) + (OUT_KDT / 2) + (size_t)id * 16384 + (size_t)((((d >> 4) * 4 + ig) * 64) + (d & 15)) * 8;
#pragma unroll
        for (int q = 0; q < 4; ++q) {
            const u32x2 r0 = *(const u32x2*)(kT + d * 132 + 32 * ig + 8 * q), r1 = *(const u32x2*)(kT + d * 132 + 32 * ig + 8 * q + 4);
            const f32x4 g0 = *(const f32x4*)(Gs + 32 * ig + 8 * q), g1 = *(const f32x4*)(Gs + 32 * ig + 8 * q + 4);
            f32x4 a = (f32x4){bflo(r0.x), bfhi(r0.x), bflo(r0.y), bfhi(r0.y)}, bb = (f32x4){bflo(r1.x), bfhi(r1.x), bflo(r1.y), bfhi(r1.y)};
#pragma unroll
            for (int e = 0; e < 4; ++e) { a[e] *= __expf(Gl - g0[e]); bb[e] *= __expf(Gl - g1[e]); }
            *(u32x4*)(dst + 128 * q) = pack8(a, bb);
        }
    }
#endif
    __syncthreads();
#ifndef DP_SKIP_SOLVE
    {
        const bool isk = w >= 4; const bf16* srcT = isk ? kT : vT; const int cb = (w & 3) * 32;
        bf16x4 X[8][2];
#pragma unroll
        for (int bi = 0; bi < 8; ++bi) {
            f32x4 bet = *(const f32x4*)(Bs + 16 * bi + 4 * fq);
            if (isk) { const f32x4 g4 = *(const f32x4*)(Gs + 16 * bi + 4 * fq); bet[0] *= __expf(g4[0]); bet[1] *= __expf(g4[1]); bet[2] *= __expf(g4[2]); bet[3] *= __expf(g4[3]); }
            f32x4 acc[2];
#pragma unroll
            for (int t = 0; t < 2; ++t) { const u32x2 raw = *(const u32x2*)(srcT + (cb + 16 * t + fr) * 132 + 16 * bi + 4 * fq);
                acc[t] = (f32x4){bflo(raw.x) * bet[0], bfhi(raw.x) * bet[1], bflo(raw.y) * bet[2], bfhi(raw.y) * bet[3]}; }
#pragma unroll
            for (int kb = 0; kb < ((DBG_SOLVE == 2 || DBG_SOLVE == 3) ? 0 : bi); ++kb) { const bf16x4 af = *(const bf16x4*)(Ab + (16 * bi + fr) * 136 + 16 * kb + 4 * fq);
                acc[0] = mfma16(af, X[kb][0], acc[0]); acc[1] = mfma16(af, X[kb][1], acc[1]); }
            const bf16x4 tf = *(const bf16x4*)(Tii + (bi * 16 + fr) * 16 + 4 * fq);
#pragma unroll
#if DBG_SOLVE == 1 || DBG_SOLVE == 3
            for (int t = 0; t < 2; ++t) X[bi][t] = pack4(acc[t]);
#else
            for (int t = 0; t < 2; ++t) X[bi][t] = pack4(mfma16(tf, pack4(acc[t]), (f32x4){0.f, 0.f, 0.f, 0.f}));
#endif
            asm volatile("" ::: "memory");
        }
        if (!isk) {
            bf16* dvp = (bf16*)(c.ws + WS_DV);
#pragma unroll
            for (int bi = 0; bi < 8; ++bi)
#pragma unroll
                for (int t = 0; t < 2; ++t) { const int cc = cb + 16 * t + fr, o = (((cc >> 4) * 8 + bi) * 16 + (cc & 15)) * 16 + 4 * fq;
                    *(bf16x4*)(dvp + (size_t)(rowbase + (o >> 7)) * 1024 + h * 128 + (o & 127)) = X[bi][t]; }
        } else {
#pragma unroll
            for (int bi = 0; bi < 8; ++bi)
#pragma unroll
                for (int t = 0; t < 2; ++t) { const u32x2 xx = __builtin_bit_cast(u32x2, X[bi][t]); const int col = cb + 16 * t + fr, r0 = 16 * bi + 4 * fq;
                    ks[(r0 + 0) * 136 + col] = (bf16)(xx.x & 0xffffu); ks[(r0 + 1) * 136 + col] = (bf16)(xx.x >> 16);
                    ks[(r0 + 2) * 136 + col] = (bf16)(xx.y & 0xffffu); ks[(r0 + 3) * 136 + col] = (bf16)(xx.y >> 16); }
        }
    }
#endif
    __syncthreads();
    {
        const int ii = tid >> 2, dg = tid & 3; bf16* dst = (bf16*)(c.out) + (OUT_W / 2) + (size_t)id * 16384 + (size_t)((((ii >> 4) * 4 + dg) * 64) + (ii & 15)) * 8;
#pragma unroll
        for (int q = 0; q < 4; ++q) *(u32x4*)(dst + 128 * q) = *(const u32x4*)(ks + ii * 136 + 32 * dg + 8 * q);
    }
    __syncthreads();
}
__device__ __forceinline__ void strip_transpose_store(bf16* dT, int ld, int c8, int j4, const u32x4 (&p)[4]) {
    const unsigned pw[4][4] = {{p[0].x, p[0].y, p[0].z, p[0].w}, {p[1].x, p[1].y, p[1].z, p[1].w}, {p[2].x, p[2].y, p[2].z, p[2].w}, {p[3].x, p[3].y, p[3].z, p[3].w}};
#pragma unroll
    for (int e = 0; e < 4; ++e) { u32x2 lo, hi;
        lo.x = (pw[0][e] & 0xffffu) | (pw[1][e] << 16); lo.y = (pw[2][e] & 0xffffu) | (pw[3][e] << 16);
        hi.x = (pw[0][e] >> 16) | (pw[1][e] & 0xffff0000u); hi.y = (pw[2][e] >> 16) | (pw[3][e] & 0xffff0000u);
        *(u32x2*)(dT + (c8 + 2 * e) * ld + j4) = lo; *(u32x2*)(dT + (c8 + 2 * e + 1) * ld + j4) = hi; }
}
__device__ __forceinline__ float ret_logg(int h) { return log1pf(-exp2f(-5.f - (float)h)); }
__device__ __forceinline__ void ret_kv(const Ctx& c, int id) {
    const int bh = id >> 5, n = id & 31, b = bh >> 3, h = bh & 7, rowbase = b * T + n * CH;
    const int tid = c.tid, fr = c.fr, fq = c.fq, w = c.wave;
    bf16* kT2 = (bf16*)c.lds; bf16* vT2 = (bf16*)(c.lds + 17408);
    const bf16* rk = (const bf16*)(c.ws + WS_RK); const bf16* rv = (const bf16*)(c.ws + WS_RV);
    const float lg = ret_logg(h);
    { const int c8 = 8 * (tid & 15), j4 = 4 * (tid >> 4); u32x4 p[4];
#pragma unroll
      for (int r = 0; r < 4; ++r) p[r] = *(const u32x4*)(rv + (size_t)(rowbase + j4 + r) * 1024 + h * 128 + c8);
      strip_transpose_store(vT2, 136, c8, j4, p); }
    if (tid < 256) { const int c8 = 8 * (tid & 7), j4 = 4 * (tid >> 3); u32x4 p[4];
#pragma unroll
      for (int r = 0; r < 4; ++r) { f32x4 a, bb; unpack8(*(const u32x4*)(rk + (size_t)(rowbase + j4 + r) * 512 + h * 64 + c8), a, bb); const float z = __expf(lg * (float)(127 - (j4 + r))); p[r] = pack8(a * z, bb * z); }
      strip_transpose_store(kT2, 136, c8, j4, p); }
    __syncthreads();
    bf16* kv = (bf16*)(c.ws + WS_KV) + (size_t)id * 8192;
#pragma unroll
    for (int dt = 0; dt < 4; ++dt) { f32x4 acc = (f32x4){0.f, 0.f, 0.f, 0.f};
#pragma unroll
        for (int kk = 0; kk < 4; ++kk) acc = mfma32(*(const bf16x8*)(kT2 + (16 * dt + fr) * 136 + 32 * kk + 8 * fq), *(const bf16x8*)(vT2 + (16 * w + fr) * 136 + 32 * kk + 8 * fq), acc);
        *(bf16x4*)(kv + (16 * w + fr) * 64 + 16 * dt + 4 * fq) = pack4(acc); }
    __syncthreads();
}

__device__ __forceinline__ void phase3(const Ctx& c) {
    const int fr = c.fr, fq = c.fq, w = c.wave, tid = c.tid;
    bf16* Sl = (bf16*)c.lds; bf16* Vl = (bf16*)(c.lds + 4352);
    const bf16* Wp0 = (const bf16*)(c.out) + (OUT_W / 2); const bf16* Kp0 = (const bf16*)(c.out) + (OUT_KDT / 2);
    bf16* dvp = (bf16*)(c.ws + WS_DV); bf16* snp = (bf16*)(c.ws + WS_SN); const float* Gc = (const float*)(c.ws + WS_GC);
    for (int wi = c.bid; wi < 256; wi += c.G) {
        const int xq = wi & 7, yq = wi >> 3, slice = yq & 7, bh = xq + 8 * (yq >> 3), b = bh >> 3, h = bh & 7;
        for (int i = tid; i < 16 * 136 / 2; i += 512) ((unsigned*)Sl)[i] = 0u;
        __syncthreads();
        f32x4 S = (f32x4){0.f, 0.f, 0.f, 0.f};
        const size_t woff = (size_t)w * 2048 + (size_t)c.lane * 8;
        const bf16* Wb = Wp0 + (size_t)(bh * 32) * 16384 + woff; const bf16* Kb = Kp0 + (size_t)(bh * 32) * 16384 + woff;
        const int o3 = ((slice * 8 + w) * 16 + fr) * 16 + 4 * fq;
        bf16* ub = dvp + (size_t)(b * T + (o3 >> 7)) * 1024 + h * 128 + (o3 & 127);
        bf16* sb = snp + (size_t)(bh * 32) * 16384 + o3;
        const float* gl = Gc + (size_t)(bh * 32) * 128 + 127;
        bf16x8 wR[4][4], kR[4][4]; bf16x4 uR[4]; float dR[4];
#define P3_LOAD(slot, n_) do { _Pragma("unroll") for (int kk = 0; kk < 4; ++kk) { wR[slot][kk] = *(const bf16x8*)(Wb + (size_t)(n_) * 16384 + 512 * kk); kR[slot][kk] = *(const bf16x8*)(Kb + (size_t)(n_) * 16384 + 512 * kk); } \
            uR[slot] = *(const bf16x4*)(ub + (size_t)(n_) * CH * 1024); dR[slot] = gl[(size_t)(n_) * 128]; } while (0)
#define P3_BAR() do { asm volatile("s_waitcnt lgkmcnt(0)" ::: "memory"); __builtin_amdgcn_s_barrier(); asm volatile("" ::: "memory"); } while (0)
#define P3_STEP(slot, n_) do { \
            *(bf16x4*)(sb + (size_t)(n_) * 16384) = pack4(S); \
            f32x4 accA = (f32x4){0.f, 0.f, 0.f, 0.f}, accB = accA; \
            accA = mfma32(wR[slot][0], *(const bf16x8*)(Sl + fr * 136 + 8 * fq), accA); accB = mfma32(wR[slot][1], *(const bf16x8*)(Sl + fr * 136 + 32 + 8 * fq), accB); \
            accA = mfma32(wR[slot][2], *(const bf16x8*)(Sl + fr * 136 + 64 + 8 * fq), accA); accB = mfma32(wR[slot][3], *(const bf16x8*)(Sl + fr * 136 + 96 + 8 * fq), accB); \
            const u32x2 ur = __builtin_bit_cast(u32x2, uR[slot]); \
            const f32x4 vn = (f32x4){bflo(ur.x) - (accA[0] + accB[0]), bfhi(ur.x) - (accA[1] + accB[1]), bflo(ur.y) - (accA[2] + accB[2]), bfhi(ur.y) - (accA[3] + accB[3])}; \
            const bf16x4 vb = pack4(vn); \
            *(bf16x4*)(ub + (size_t)(n_) * CH * 1024) = vb; \
            *(bf16x4*)(Vl + fr * 136 + 16 * w + 4 * fq) = vb; \
            P3_BAR(); \
            f32x4 acC = (f32x4){0.f, 0.f, 0.f, 0.f}, acD = acC; \
            acC = mfma32(kR[slot][0], *(const bf16x8*)(Vl + fr * 136 + 8 * fq), acC); acD = mfma32(kR[slot][1], *(const bf16x8*)(Vl + fr * 136 + 32 + 8 * fq), acD); \
            acC = mfma32(kR[slot][2], *(const bf16x8*)(Vl + fr * 136 + 64 + 8 * fq), acC); acD = mfma32(kR[slot][3], *(const bf16x8*)(Vl + fr * 136 + 96 + 8 * fq), acD); \
            S = S * __expf(dR[slot]) + (acC + acD); \
            *(bf16x4*)(Sl + fr * 136 + 16 * w + 4 * fq) = pack4(S); \
            P3_BAR(); } while (0)
        P3_LOAD(0, 0); P3_LOAD(1, 1); P3_LOAD(2, 2); P3_LOAD(3, 3);
#pragma unroll
        for (int n4 = 0; n4 < NCH; n4 += 4) {
            const int np = (n4 + 4 < NCH) ? 4 : 0;
            P3_STEP(0, n4);     P3_LOAD(0, n4 + np);
            P3_STEP(1, n4 + 1); P3_LOAD(1, n4 + np + (np ? 1 : 0));
            P3_STEP(2, n4 + 2); P3_LOAD(2, n4 + np + (np ? 2 : 0));
            P3_STEP(3, n4 + 3); P3_LOAD(3, n4 + np + (np ? 3 : 0));
        }
#undef P3_LOAD
#undef P3_STEP
#undef P3_BAR
        __syncthreads();
    }
    for (int gid = c.bid * 512 + tid; gid < 32 * 4096; gid += c.G * 512) {
        const int bh = gid >> 12, e = gid & 4095, h = bh & 7; const float decay = __expf(128.f * ret_logg(h));
        unsigned* p = (unsigned*)(c.ws + WS_KV) + (size_t)(bh * 32) * 4096 + e; float s0 = 0.f, s1 = 0.f;
#pragma unroll 8
        for (int n = 0; n < NCH; ++n) { const unsigned raw = p[(size_t)n * 4096]; p[(size_t)n * 4096] = pk2(s0, s1); s0 = s0 * decay + bflo(raw); s1 = s1 * decay + bfhi(raw); }
    }
}

struct DnPre { u32x4 kk[4], vv[4], ss[4], qraw[7]; float g; };
__device__ __forceinline__ void dn_out_load(const Ctx& c, int id, DnPre& p) {
    const int bh = id >> 5, n = id & 31, b = bh >> 3, h = bh & 7, rowbase = b * T + n * CH; const int tid = c.tid, fr = c.fr, fq = c.fq, w = c.wave;
    const bf16* dq = (const bf16*)(c.ws + WS_DQ); const bf16* dk = (const bf16*)(c.ws + WS_DK); const bf16* dv = (const bf16*)(c.ws + WS_DV); const bf16* sn = (const bf16*)(c.ws + WS_SN) + (size_t)id * 16384;
#pragma unroll
    for (int s = 0; s < 4; ++s) { const int idx = tid + 512 * s, r = idx >> 4, c8 = (idx & 15) * 8;
        const int o = 8 * idx;
        p.kk[s] = *(const u32x4*)(dk + (size_t)(rowbase + r) * 1024 + h * 128 + c8); p.vv[s] = *(const u32x4*)(dv + (size_t)(rowbase + (o >> 7)) * 1024 + h * 128 + (o & 127)); p.ss[s] = *(const u32x4*)(sn + o); }
    { const bf16* halo = (const bf16*)(c.ws + WS_HALO); const int col8 = 8 * (tid & 15), i4 = 4 * (tid >> 4);
#pragma unroll
      for (int k = 0; k < 7; ++k) { const int rr = i4 - 3 + k; u32x4 r = (u32x4){0u, 0u, 0u, 0u};
          if (rr >= 0) r = *(const u32x4*)(dq + (size_t)(rowbase + rr) * 1024 + h * 128 + col8);
          else if (n > 0) r = *(const u32x4*)(halo + ((size_t)(b * 32 + n - 1) * 3 + (rr + 3)) * 3072 + h * 128 + col8);
          p.qraw[k] = r; } }
    p.g = (tid < 128) ? ((const float*)(c.ws + WS_GC))[(size_t)id * 128 + tid] : 0.f;
}
__device__ __forceinline__ void dn_out(const Ctx& c, int id, int next_id, DnPre& p) {
    const int bh = id >> 5, n = id & 31, b = bh >> 3, h = bh & 7, rowbase = b * T + n * CH;
    const int tid = c.tid, fr = c.fr, fq = c.fq, w = c.wave;
    bf16* ksl = (bf16*)c.lds; bf16* snl = (bf16*)(c.lds + 34816); bf16* vl = (bf16*)(c.lds + 69632); float* Gs = (float*)(c.lds + 104448);
    bf16* dv = (bf16*)(c.ws + WS_DV);
#pragma unroll
    for (int s = 0; s < 4; ++s) { const int idx = tid + 512 * s, r = idx >> 4, c8 = (idx & 15) * 8;
        const int o = 8 * idx, cT = (((o >> 11) & 7) << 4) | ((o >> 4) & 15), iT = (((o >> 8) & 7) << 4) | (o & 15);
        *(u32x4*)(ksl + r * 136 + c8) = p.kk[s]; *(u32x4*)(vl + cT * 136 + iT) = p.vv[s]; *(u32x4*)(snl + cT * 136 + iT) = p.ss[s]; }
    if (tid < 128) Gs[tid] = p.g;
    bf16* qsl = (bf16*)(c.lds + 104960);
    { const int col8 = 8 * (tid & 15), i4 = 4 * (tid >> 4);
      f32x4 w0[4], w1[4];
#pragma unroll
      for (int k = 0; k < 4; ++k) { const float* wp = c.dn_conv_w + (size_t)k * 3072 + h * 128 + col8; w0[k] = *(const f32x4*)wp; w1[k] = *(const f32x4*)(wp + 4); }
#pragma unroll
      for (int r = 0; r < 4; ++r) { f32x4 a0 = (f32x4){0.f, 0.f, 0.f, 0.f}, a1 = a0;
#pragma unroll
          for (int k = 0; k < 4; ++k) { f32x4 x0, x1; unpack8(p.qraw[r + k], x0, x1); a0 = a0 + x0 * w0[k]; a1 = a1 + x1 * w1[k]; }
          float sq = 0.f;
#pragma unroll
          for (int e = 0; e < 4; ++e) { a0[e] = silu_f(a0[e]); a1[e] = silu_f(a1[e]); sq += a0[e] * a0[e] + a1[e] * a1[e]; }
          sq += __shfl_xor(sq, 1); sq += __shfl_xor(sq, 2); sq += __shfl_xor(sq, 4); sq += __shfl_xor(sq, 8);
          const float rn = rsqrtf(sq + EPS);
          *(u32x4*)(qsl + (i4 + r) * 136 + col8) = pack8(a0 * rn, a1 * rn); } }
    __syncthreads();
    dn_out_load(c, next_id, p);
    const int i0 = 16 * w, i = i0 + fr; const float scale = 0.08838834764831845f;
    bf16x8 qA[4];
#pragma unroll
    for (int kk = 0; kk < 4; ++kk) qA[kk] = *(const bf16x8*)(qsl + i * 136 + 32 * kk + 8 * fq);
    const float Gi = Gs[i], rowsc = __expf(Gi) * scale;
    f32x4 O[8];
#pragma unroll
    for (int ct = 0; ct < 8; ++ct) { f32x4 acc = (f32x4){0.f, 0.f, 0.f, 0.f};
#pragma unroll
        for (int kk = 0; kk < 4; ++kk) acc = mfma32(*(const bf16x8*)(snl + (16 * ct + fr) * 136 + 32 * kk + 8 * fq), qA[kk], acc);
        O[ct] = acc * rowsc; }
    for (int jt = 0; jt <= w; ++jt) {
        f32x4 p = (f32x4){0.f, 0.f, 0.f, 0.f};
#pragma unroll
        for (int kk = 0; kk < 4; ++kk) p = mfma32(*(const bf16x8*)(ksl + (16 * jt + fr) * 136 + 32 * kk + 8 * fq), qA[kk], p);
        const f32x4 G4 = *(const f32x4*)(Gs + 16 * jt + 4 * fq);
#pragma unroll
        for (int r = 0; r < 4; ++r) { const int j = 16 * jt + 4 * fq + r; p[r] = (i >= j) ? p[r] * scale * __expf(Gi - G4[r]) : 0.f; }
        const bf16x4 pb = pack4(p);
#pragma unroll
        for (int ct = 0; ct < 8; ++ct) O[ct] = mfma16(*(const bf16x4*)(vl + (16 * ct + fr) * 136 + 16 * jt + 4 * fq), pb, O[ct]);
    }
    float ssq = 0.f;
#pragma unroll
    for (int ct = 0; ct < 8; ++ct) ssq += (O[ct][0] * O[ct][0] + O[ct][1] * O[ct][1]) + (O[ct][2] * O[ct][2] + O[ct][3] * O[ct][3]);
    ssq += __shfl_xor(ssq, 16); ssq += __shfl_xor(ssq, 32);
    const float rstd = rsqrtf(ssq * (1.f / 128.f) + EPS);
#pragma unroll
    for (int ct = 0; ct < 8; ++ct) { const int cc = 16 * ct + 4 * fq; const f32x4 g4 = *(const f32x4*)(c.dn_norm_g + cc);
        *(bf16x4*)(dv + (size_t)(rowbase + i) * 1024 + h * 128 + cc) = pack4(O[ct] * rstd * g4); }
    __syncthreads();
}
__device__ __forceinline__ void ret_out(const Ctx& c, int id) {
    const int bh = id >> 5, n = id & 31, b = bh >> 3, h = bh & 7, rowbase = b * T + n * CH;
    const int tid = c.tid, fr = c.fr, fq = c.fq, w = c.wave;
    bf16* ksl = (bf16*)c.lds; bf16* snl = (bf16*)(c.lds + 18432); bf16* vl = (bf16*)(c.lds + 36864);
    const bf16* rq = (const bf16*)(c.ws + WS_RQ); const bf16* rk = (const bf16*)(c.ws + WS_RK); bf16* rv = (bf16*)(c.ws + WS_RV); const bf16* sp = (const bf16*)(c.ws + WS_KV) + (size_t)id * 8192;
#pragma unroll
    for (int s = 0; s < 2; ++s) { const int idx = tid + 512 * s, r = idx >> 3, c8 = (idx & 7) * 8;
        *(u32x4*)(ksl + r * 72 + c8) = *(const u32x4*)(rk + (size_t)(rowbase + r) * 512 + h * 64 + c8);
        *(u32x4*)(snl + r * 72 + c8) = *(const u32x4*)(sp + r * 64 + c8); }
    { const int c8 = 8 * (tid & 15), j4 = 4 * (tid >> 4); u32x4 p[4];
#pragma unroll
      for (int r = 0; r < 4; ++r) p[r] = *(const u32x4*)(rv + (size_t)(rowbase + j4 + r) * 1024 + h * 128 + c8);
      strip_transpose_store(vl, 136, c8, j4, p); }
    __syncthreads();
    const int i0 = 16 * w, i = i0 + fr; const float lg = ret_logg(h);
    bf16x8 qA[2];
#pragma unroll
    for (int kk = 0; kk < 2; ++kk) qA[kk] = *(const bf16x8*)(rq + (size_t)(rowbase + i) * 512 + h * 64 + 32 * kk + 8 * fq);
    const float xi = __expf(lg * (float)(i + 1));
    f32x4 O[8];
#pragma unroll
    for (int ct = 0; ct < 8; ++ct) { f32x4 acc = (f32x4){0.f, 0.f, 0.f, 0.f};
#pragma unroll
        for (int kk = 0; kk < 2; ++kk) acc = mfma32(*(const bf16x8*)(snl + (16 * ct + fr) * 72 + 32 * kk + 8 * fq), qA[kk], acc);
        O[ct] = acc * xi; }
    for (int jt = 0; jt <= w; ++jt) {
        f32x4 p = (f32x4){0.f, 0.f, 0.f, 0.f};
#pragma unroll
        for (int kk = 0; kk < 2; ++kk) p = mfma32(*(const bf16x8*)(ksl + (16 * jt + fr) * 72 + 32 * kk + 8 * fq), qA[kk], p);
#pragma unroll
        for (int r = 0; r < 4; ++r) { const int j = 16 * jt + 4 * fq + r; p[r] = (i >= j) ? p[r] * __expf(lg * (float)(i - j)) : 0.f; }
        const bf16x4 pb = pack4(p);
#pragma unroll
        for (int ct = 0; ct < 8; ++ct) O[ct] = mfma16(*(const bf16x4*)(vl + (16 * ct + fr) * 136 + 16 * jt + 4 * fq), pb, O[ct]);
    }
    float sm = 0.f;
#pragma unroll
    for (int ct = 0; ct < 8; ++ct) sm += (O[ct][0] + O[ct][1]) + (O[ct][2] + O[ct][3]);
    sm += __shfl_xor(sm, 16); sm += __shfl_xor(sm, 32);
    const float mu = sm * (1.f / 128.f); float vs = 0.f;
#pragma unroll
    for (int ct = 0; ct < 8; ++ct) { O[ct] = O[ct] - mu; vs += (O[ct][0] * O[ct][0] + O[ct][1] * O[ct][1]) + (O[ct][2] * O[ct][2] + O[ct][3] * O[ct][3]); }
    vs += __shfl_xor(vs, 16); vs += __shfl_xor(vs, 32);
    const float rstd = rsqrtf(vs * (1.f / 128.f) + GN_EPS);
#pragma unroll
    for (int ct = 0; ct < 8; ++ct) { const int cc = 16 * ct + 4 * fq; const f32x4 g4 = *(const f32x4*)(c.ret_norm_g + h * 128 + cc);
        *(bf16x4*)(rv + (size_t)(rowbase + i) * 1024 + h * 128 + cc) = pack4(O[ct] * rstd * g4); }
    __syncthreads();
}

__device__ __forceinline__ void ffn_fixup(const Ctx& c, int pm) {
    bf16* act = (bf16*)(c.ws + WS_ACT); const bf16* hbuf = (const bf16*)(c.ws + WS_HBUF);
    constexpr int NJ4 = DFF / 4;
    for (int idx = c.tid; idx < 8 * NJ4; idx += 512) {
        const int j0 = (idx % NJ4) * 4, gr = idx / NJ4, g = 4 * pm + (gr >> 1), r = gr & 1, col = 2 * j0;
        const bool first = ((g * 64) & (T - 1)) == 0;
        u32x4 u0, u1 = (u32x4){0u, 0u, 0u, 0u}, u2 = u1;
        u0 = *(const u32x4*)(hbuf + ((size_t)g * 4 + r) * NUP + col);
        if (r == 1) { u1 = *(const u32x4*)(hbuf + ((size_t)g * 4 + 0) * NUP + col); if (!first) u2 = *(const u32x4*)(hbuf + ((size_t)(g - 1) * 4 + 3) * NUP + col); }
        else if (!first) { u1 = *(const u32x4*)(hbuf + ((size_t)(g - 1) * 4 + 3) * NUP + col); u2 = *(const u32x4*)(hbuf + ((size_t)(g - 1) * 4 + 2) * NUP + col); }
        f32x4 c0, c1, p10, p11, p20, p21; unpack8(u0, c0, c1); unpack8(u1, p10, p11); unpack8(u2, p20, p21);
        f32x4 wa[3], wb[3];
#pragma unroll
        for (int k = 0; k < 3; ++k) { wa[k] = *(const f32x4*)(c.ffn_conv_w + (size_t)k * NUP + j0); wb[k] = *(const f32x4*)(c.ffn_conv_w + (size_t)k * NUP + DFF + j0); }
        const f32x4 ba = *(const f32x4*)(c.ffn_conv_b + j0), bb = *(const f32x4*)(c.ffn_conv_b + DFF + j0);
        const f32x4 xa = (f32x4){c0[0], c0[2], c1[0], c1[2]}, xb = (f32x4){c0[1], c0[3], c1[1], c1[3]};
        const f32x4 xa1 = (f32x4){p10[0], p10[2], p11[0], p11[2]}, xb1 = (f32x4){p10[1], p10[3], p11[1], p11[3]};
        const f32x4 xa2 = (f32x4){p20[0], p20[2], p21[0], p21[2]}, xb2 = (f32x4){p20[1], p20[3], p21[1], p21[3]};
        const f32x4 ya = wa[0] * xa2 + wa[1] * xa1 + wa[2] * xa + ba, yb = wb[0] * xb2 + wb[1] * xb1 + wb[2] * xb + bb;
        f32x4 o;
#pragma unroll
        for (int e = 0; e < 4; ++e) o[e] = silu_f(ya[e]) * yb[e];
        *(bf16x4*)(act + (size_t)(g * 64 + r) * DFF + j0) = pack4(o);
    }
}

#define XB_TMO      128
#define XB_XCNT(j)  (256  + 64 * (j))
#define XB_XSUB(j)  (1280 + 64 * (j))
#define XB_XGEN(j)  (2304 + 64 * (j))
#define XB_TOP      3328
#define XB_TOPGEN   3392
#define XCD_BAR_WORDS 3456
#define XB_SPIN_CAP (1u << 18)

__device__ __forceinline__ unsigned xb_ld(unsigned* p)              { return __hip_atomic_load(p, __ATOMIC_RELAXED, __HIP_MEMORY_SCOPE_AGENT); }
__device__ __forceinline__ unsigned xb_add(unsigned* p, unsigned v) { return __hip_atomic_fetch_add(p, v, __ATOMIC_RELAXED, __HIP_MEMORY_SCOPE_AGENT); }
__device__ __forceinline__ unsigned xb_xcc_id() { return (unsigned)__builtin_amdgcn_s_getreg((3 << 11) | 20) & 0xFu; }
#define XB_SPIN(cond, bar) do { unsigned _sp = 0; while (cond) { __builtin_amdgcn_s_sleep(1); \
    if ((++_sp & 255u) == 0u) { if (xb_ld(&(bar)[XB_TMO])) break; if (_sp > XB_SPIN_CAP) { atomicAdd(&(bar)[XB_TMO], 1u); break; } } } } while (0)

struct XcdBarrier {
    unsigned* bar; unsigned x;
    volatile PG8_LAS unsigned* st;
};

__device__ __forceinline__ XcdBarrier xcd_barrier_post(unsigned* bar, volatile PG8_LAS unsigned* st) {
    XcdBarrier b; b.bar = bar; b.x = xb_xcc_id(); b.st = st;
    if (threadIdx.x == 0) (void)xb_add(&bar[XB_XCNT(b.x)], 1u);
    return b;
}
__device__ __forceinline__ void xcd_barrier_complete(unsigned* bar, unsigned x, unsigned& nloc, unsigned& nx) {
    const unsigned G = gridDim.x * gridDim.y * gridDim.z;
    unsigned sum, cnt, mine, sp = 0u;
    for (;;) {
        sum = 0u; cnt = 0u; mine = 0u;
#pragma unroll
        for (unsigned j = 0; j < 16; ++j) { const unsigned c = xb_ld(&bar[XB_XCNT(j)]); sum += c; cnt += (c > 0u) ? 1u : 0u; mine = (j == x) ? c : mine; }
        if (sum == G) break;
        __builtin_amdgcn_s_sleep(1);
        if ((++sp & 255u) == 0u) { if (xb_ld(&bar[XB_TMO])) break; if (sp > XB_SPIN_CAP) { atomicAdd(&bar[XB_TMO], 1u); break; } }
    }
    nloc = mine > 0u ? mine : 1u; nx = cnt > 0u ? cnt : 1u;
}

__device__ __forceinline__ void xcd_barrier(const XcdBarrier& b) {
    asm volatile("s_waitcnt vmcnt(0)" ::: "memory");
    __syncthreads();
    if (threadIdx.x == 0) {
        unsigned* bar = b.bar;
        __builtin_amdgcn_s_waitcnt(0);
        unsigned nloc = b.st[0], nx = b.st[1];
        if (nloc == 0u) { xcd_barrier_complete(bar, b.x, nloc, nx); b.st[0] = nloc; b.st[1] = nx; }
        const unsigned old = xb_add(&bar[XB_XSUB(b.x)], 1u);
        const unsigned gen = old / nloc;
        if (old + 1u == (gen + 1u) * nloc) {
            __builtin_amdgcn_fence(__ATOMIC_RELEASE, "agent");
            asm volatile("s_waitcnt vmcnt(0)" ::: "memory");
            const unsigned og = xb_add(&bar[XB_TOP], 1u);
            const unsigned tg = og / nx;
            if (og + 1u == (tg + 1u) * nx) xb_add(&bar[XB_TOPGEN], 1u);
            else XB_SPIN(xb_ld(&bar[XB_TOPGEN]) == tg, bar);
            __builtin_amdgcn_fence(__ATOMIC_ACQUIRE, "agent");
            xb_add(&bar[XB_XGEN(b.x)], 1u);
            asm volatile("s_waitcnt vmcnt(0)" ::: "memory");
        } else {
            XB_SPIN(xb_ld(&bar[XB_XGEN(b.x)]) == gen, bar);
            __builtin_amdgcn_fence(__ATOMIC_ACQUIRE, "agent");
            asm volatile("s_waitcnt vmcnt(0)" ::: "memory");
        }
    }
    __syncthreads();
}

struct PairOrder {
    pg8::StaticOrder base;
    __device__ bool next(int i, pg8::Unit& u) const { if (!base.next(i >> 1, u)) return false; if (i & 1) { u.pm += 192; u.pn += 4; } return true; }
    __device__ __forceinline__ void a_ready(const pg8::Unit&) const {}
    __device__ __forceinline__ void done(const pg8::Unit&) const {}
};
struct Epi6 {
    static constexpr bool PERM = true, AFTER_DRAIN = false; bf16* sigr; const bf16* sigd;
    __device__ __forceinline__ void operator()(const pg8::f32x4 (&acc)[2][2][4][2], const pg8::Unit& u, int wr, int wc, int fr, int fq) const {
        const bool second = u.pn >= 4; const int pm = second ? u.pm - 192 : u.pm, pn = second ? u.pn - 4 : u.pn;
#pragma unroll
        for (int ai = 0; ai < 2; ++ai)
#pragma unroll
            for (int m = 0; m < 4; ++m) { const int row = pm * 256 + ai * 128 + wr * 64 + m * 16 + fr;
#pragma unroll
                for (int bj = 0; bj < 2; ++bj) { const int col = pn * 256 + bj * 128 + wc * 32 + 8 * fq; bf16* p = sigr + (size_t)row * 1024 + col;
                    f32x4 a, b; unpack8(*(const u32x4*)p, a, b);
                    if (!second) { a = a * acc[ai][bj][m][0]; b = b * acc[ai][bj][m][1]; }
                    else { f32x4 s0, s1; unpack8(*(const u32x4*)(sigd + (size_t)row * 1024 + col), s0, s1); a = a + s0 * acc[ai][bj][m][0]; b = b + s1 * acc[ai][bj][m][1]; }
                    *(u32x4*)p = pack8(a, b); } }
    }
};
template <int K> __device__ __forceinline__ void run_phase(const Ctx& c, unsigned char* lds, PG8_LAS unsigned char* ldsl, unsigned char* ws, bf16* outb) {

    if constexpr (K == 0) phase0(c);
    if constexpr (K == 1) {
        pg8::Gemm g{(const bf16*)(ws + WS_UX), (const bf16*)(ws + WS_WIN) + (size_t)N5 * 1024, M, N1, 1024, 1024, 1024}; pg8::StaticOrder S; S.init(M, N1, c.G, c.bid);
        EpiRow8<F1> E{F1{(const float*)(ws + WS_R1), (const float*)(ws + WS_ROPE), (bf16*)(ws + WS_RQ), (bf16*)(ws + WS_RK), (bf16*)(ws + WS_RV), (bf16*)(ws + WS_DQ), (bf16*)(ws + WS_HALO)}};
        pg8::gemm_phase<EpiRow8<F1>, pg8::StaticOrder, true, true>(ldsl, g, S, E);
    }
    if constexpr (K == 2) {
        for (int id = c.bid; id < 1024; id += c.G) dn_prep(c, id);
        for (int id = c.bid; id < 1024; id += c.G) ret_kv(c, id);
    }
    if constexpr (K == 3) phase3(c);
    if constexpr (K == 4) {
#ifndef DBG_SKIP_OUT
        { DnPre pre; if (c.bid < 1024) dn_out_load(c, c.bid, pre);
          for (int id = c.bid; id < 1024; id += c.G) dn_out(c, id, (id + c.G < 1024) ? id + c.G : id, pre); }
        for (int id = c.bid; id < 1024; id += c.G) ret_out(c, id);
#endif
    }
    if constexpr (K == 5) {
        {
          float* scr = (float*)(lds + c.wave * 16384); const int gw = c.bid * 8 + c.wave, ngw = c.G * 8;
          constexpr int I_SQ = 16 * 32, I_UP = 16 * (NUP / 32), I_DN = (DFF / 64) * 32;
          for (int it = gw; it < 3 * I_SQ + I_UP + I_DN; it += ngw) {
              if (it < I_SQ) transpose_item<0>(c.w_ret_br, 1024, 1024, (bf16*)(ws + WS_WRET), nullptr, scr, it, 32, c.lane);
              else if (it < 2 * I_SQ) transpose_item<0>(c.w_dn_br, 1024, 1024, (bf16*)(ws + WS_WDN), nullptr, scr, it - I_SQ, 32, c.lane);
              else if (it < 3 * I_SQ) transpose_item<0>(c.w_o, 1024, 1024, (bf16*)(ws + WS_WO), nullptr, scr, it - 2 * I_SQ, 32, c.lane);
              else if (it < 3 * I_SQ + I_UP) transpose_item<2>(c.w_up, 1024, NUP, (bf16*)(ws + WS_WUP), c.g_ffn, scr, it - 3 * I_SQ, NUP / 32, c.lane);
              else transpose_item<0>(c.w_down, DFF, 1024, (bf16*)(ws + WS_WDOWN), nullptr, scr, it - 3 * I_SQ - I_UP, 32, c.lane); }
          __syncthreads(); }
        pg8::Gemm g{(const bf16*)(ws + WS_UX), (const bf16*)(ws + WS_WIN), M, N5, 1024, 1024, 1024}; pg8::StaticOrder S; S.init(M, N5, c.G, c.bid);
        EpiRow8<F5> E{F5{(const float*)(ws + WS_R1), (bf16*)(ws + WS_RV), (bf16*)(ws + WS_DV), (bf16*)(ws + WS_DQ), (bf16*)(ws + WS_DK)}};
        pg8::gemm_phase<EpiRow8<F5>, pg8::StaticOrder, true, true>(ldsl, g, S, E);
    }
    if constexpr (K == 6) {
        static_assert(WS_DV - WS_RV == (size_t)192 * 256 * 1024 * 2 && WS_WDN - WS_WRET == (size_t)4 * 256 * 1024 * 2, "tile offsets of the second GEMM");
        PairOrder S; S.base.init(M, 1024, c.G, c.bid);
        pg8::Gemm g{(const bf16*)(ws + WS_RV), (const bf16*)(ws + WS_WRET), M, 1024, 1024, 1024, 1024};
        Epi6 E{(bf16*)(ws + WS_DQ), (const bf16*)(ws + WS_DK)};
        pg8::gemm_phase<Epi6, PairOrder, true, true>(ldsl, g, S, E);
    }
    if constexpr (K == 7) {
        pg8::Gemm g{(const bf16*)(ws + WS_DQ), (const bf16*)(ws + WS_WO), M, 1024, 1024, 1024, 1024}; pg8::StaticOrder S; S.init(M, 1024, c.G, c.bid);
        EpiRes<true> E{c.x, (bf16*)(ws + WS_H1B), (float*)(ws + WS_SS1)};
        pg8::gemm_phase<EpiRes<true>, pg8::StaticOrder, true, true>(ldsl, g, S, E);
    }
    if constexpr (K == 8) {
        pg8::Gemm g{(const bf16*)(ws + WS_H1B), (const bf16*)(ws + WS_WUP), M, NUP, 1024, 1024, 1024}; pg8::StaticOrder S; S.init(M, NUP, c.G, c.bid);
        Epi8 E{(const float*)(ws + WS_SS1), (bf16*)(ws + WS_ACT), (bf16*)(ws + WS_HBUF), c.ffn_conv_w, c.ffn_conv_b};
        pg8::gemm_phase<Epi8, pg8::StaticOrder, true, true>(ldsl, g, S, E);
#ifdef TIMING_DUP_P8
        __syncthreads();
        pg8::gemm_phase<Epi8, pg8::StaticOrder, true, true>(ldsl, g, S, E);
#endif
    }
    if constexpr (K == 10) {
        pg8::Gemm g{(const bf16*)(ws + WS_ACT), (const bf16*)(ws + WS_WDOWN), M, 1024, DFF, DFF, DFF}; pg8::StaticOrder S; S.init(M, 1024, c.G, c.bid);
        { pg8::Unit u; int last_pm = -1; for (int i = 0; S.next(i, u); ++i) if (u.pm != last_pm) { ffn_fixup(c, u.pm); last_pm = u.pm; }
          asm volatile("s_waitcnt vmcnt(0)" ::: "memory"); __syncthreads(); }
        EpiRes<false> E{nullptr, (bf16*)(ws + WS_H1B), (float*)(ws + WS_SS2)};
        pg8::gemm_phase<EpiRes<false>, pg8::StaticOrder, true, true>(ldsl, g, S, E);
    }
    if constexpr (K == 11) {
        const float* ss2 = (const float*)(ws + WS_SS2);
        for (int row = c.bid * 8 + c.wave; row < M; row += c.G * 8) {
            const float pv = (c.lane < 16) ? ss2[(size_t)row * 16 + c.lane] : 0.f; float s = pv;
#pragma unroll
            for (int o = 1; o < 16; o <<= 1) s += __shfl_xor(s, o);
            s = __shfl(s, 0);
            const float r = rsqrtf(s * (1.f / 1024.f) + EPS);
            f32x4* p = (f32x4*)(c.out + (size_t)row * 1024) + 2 * c.lane; const u32x4* hp = (const u32x4*)((const bf16*)(ws + WS_H1B) + (size_t)row * 1024) + c.lane;
#pragma unroll
            for (int j = 0; j < 2; ++j) { f32x4 a0, a1; unpack8(hp[64 * j], a0, a1);
                const f32x4 g0 = *((const f32x4*)c.g_final + 128 * j + 2 * c.lane), g1 = *((const f32x4*)c.g_final + 128 * j + 2 * c.lane + 1);
                p[128 * j] = a0 * r * g0; p[128 * j + 1] = a1 * r * g1; }
        }
    }

}
struct Args { const float* in[17]; float* out; unsigned char* ws; int ph_lo, ph_hi; };
__global__ void __launch_bounds__(512) fwd_kernel(Args args) {
    extern __shared__ __attribute__((aligned(16))) unsigned char lds[];
    cg::grid_group grid = cg::this_grid();
    Ctx c;
    c.x = args.in[0]; c.g_mix = args.in[1]; c.w_in = args.in[2]; c.ret_norm_g = args.in[3]; c.dn_conv_w = args.in[4]; c.dn_a_log = args.in[5]; c.dn_dt_bias = args.in[6]; c.dn_norm_g = args.in[7];
    c.w_ret_br = args.in[8]; c.w_dn_br = args.in[9]; c.w_o = args.in[10]; c.g_ffn = args.in[11]; c.w_up = args.in[12]; c.ffn_conv_w = args.in[13]; c.ffn_conv_b = args.in[14]; c.w_down = args.in[15]; c.g_final = args.in[16];
    c.out = args.out; c.ws = args.ws; c.lds = lds;
    c.tid = threadIdx.x; c.lane = c.tid & 63; c.wave = __builtin_amdgcn_readfirstlane(c.tid >> 6); c.bid = blockIdx.x; c.G = gridDim.x; c.fr = c.lane & 15; c.fq = c.lane >> 4;
    PG8_LAS unsigned char* ldsl = (PG8_LAS unsigned char*)lds;
    const int lo = args.ph_lo, hi = args.ph_hi;
    unsigned char* ws = args.ws;
    bf16* outb = (bf16*)args.out;
#ifndef PROGRAM_STEPS
#define PROGRAM_STEPS STEP(0, 0) STEP(1, 1) STEP(2, 2) STEP(3, 3) STEP(4, 4) STEP(5, 5) STEP(6, 6) STEP(7, 7) STEP(8, 8) STEP(9, 10) STEP(10, 11)
#endif
    volatile PG8_LAS unsigned* bst = (volatile PG8_LAS unsigned*)(ldsl + LDS_BYTES - 64);
    if (c.tid < 16) bst[c.tid] = 0u;
    __syncthreads();
    XcdBarrier bar = xcd_barrier_post((unsigned*)(ws + WS_CTL), bst);
    if (lo == 0 && hi > 1) grid.sync();
#define STEP(i, k) if (lo <= (i) && (i) < hi) run_phase<k>(c, lds, ldsl, ws, outb); if (lo <= (i) && (i) + 1 < hi) xcd_barrier(bar);
    PROGRAM_STEPS
#undef STEP
#ifdef DBG_DUMP_OFF
    if (lo == 12) {
        const bf16* src = (const bf16*)(ws + (size_t)DBG_DUMP_OFF);
        for (size_t idx = (size_t)c.bid * 512 + c.tid; idx < (size_t)M * 1024; idx += (size_t)c.G * 512) { float v = bf2f(src[idx]); c.out[idx] = (v == v && fabsf(v) < 1e30f) ? v : 12345.f; }
    }
#endif
}

extern "C" void kernel_launch(void* const* d_in, const int* in_sizes, int n_in, void* d_out, int out_size, void* d_ws, size_t ws_size, hipStream_t stream) {
    static int grid = 0;
    if (grid == 0) {
        if (n_in != 17 || out_size != M * D || ws_size < WS_END) { fprintf(stderr, "kernel_launch: unexpected shapes (n_in %d out %d ws %zu)\n", n_in, out_size, ws_size); grid = -1; return; }
        int dev = 0, cus = 0, per_cu = 0;
        if (hipGetDevice(&dev) != hipSuccess || hipDeviceGetAttribute(&cus, hipDeviceAttributeMultiprocessorCount, dev) != hipSuccess) { grid = -1; return; }
        if (hipFuncSetAttribute((const void*)fwd_kernel, hipFuncAttributeMaxDynamicSharedMemorySize, LDS_BYTES) != hipSuccess) { fprintf(stderr, "kernel_launch: hipFuncSetAttribute failed\n"); grid = -1; return; }
        if (hipOccupancyMaxActiveBlocksPerMultiprocessor(&per_cu, (const void*)fwd_kernel, 512, LDS_BYTES) != hipSuccess || per_cu < 1) { fprintf(stderr, "kernel_launch: occupancy query says %d\n", per_cu); per_cu = 1; }
        (void)hipGetLastError();
        grid = cus;
    }
    if (grid < 0) return;
    Args a{};
    for (int i = 0; i < 17; ++i) a.in[i] = (const float*)d_in[i];
    a.out = (float*)d_out; a.ws = (unsigned char*)d_ws;
#if N_LAUNCH_MODE == 1
    if (hipMemsetAsync((char*)d_ws + WS_CTL, 0, CTL_BYTES, stream) != hipSuccess) { fprintf(stderr, "kernel_launch: memset of the barrier words failed\n"); return; }
    a.ph_lo = 0; a.ph_hi = NPHASE;
    void* kargs[] = {&a};
    hipError_t e = hipLaunchCooperativeKernel((const void*)fwd_kernel, dim3(grid), dim3(512), kargs, LDS_BYTES, stream);
    if (e != hipSuccess) fprintf(stderr, "kernel_launch: cooperative launch failed: %s (grid %d)\n", hipGetErrorString(e), grid);
#else
    for (int ph = 0; ph < NPHASE; ++ph) { a.ph_lo = ph; a.ph_hi = ph + 1; hipLaunchKernelGGL(fwd_kernel, dim3(grid), dim3(512), LDS_BYTES, stream, a); }
#ifdef DBG_DUMP_OFF
    a.ph_lo = 12; a.ph_hi = 13; hipLaunchKernelGGL(fwd_kernel, dim3(grid), dim3(512), LDS_BYTES, stream, a);
#endif
#endif
}
```

```cpp
#include <hip/hip_runtime.h>
#include <hip/hip_cooperative_groups.h>
#include <cstdio>
#include <cstdint>
namespace cg = cooperative_groups;
namespace pg8 {
#define PG8_LAS __attribute__((address_space(3)))
typedef unsigned short bf16_t;
typedef short bf16x8 __attribute__((ext_vector_type(8)));
typedef float f32x4 __attribute__((ext_vector_type(4)));
typedef unsigned u32x4 __attribute__((ext_vector_type(4)));
constexpr int BM = 256, BK = 64, HALF = 128, HTB = HALF * BK * 2  , STAGE_BYTES = 8 * HTB, NXCD = 8, WGM = 4;

__host__ __device__ __forceinline__ int lds_byte(int r, int c) { const int st = (r >> 4) * 2 + (c >> 5), rr = r & 15, cc = c & 31, ob = rr * 64 + cc * 2; return st * 1024 + (ob ^ (((ob >> 9) & 1) << 5)); }
__host__ __device__ __forceinline__ void stage_rc(int b, int& R, int& C) { const int st = b / 1024, sb = b % 1024, swz = sb ^ (((sb >> 9) & 1) << 5); R = (st >> 1) * 16 + swz / 64; C = (st & 1) * 32 + (swz % 64) / 2; }
__host__ __device__ __forceinline__ int perm32(int rho) { const int n = rho >> 4, i = rho & 15; return 8 * (i >> 2) + 4 * n + (i & 3); }

struct Unit { int pm, pn; };
struct Gemm { const bf16_t* A; const bf16_t* Bt; int M, N, K, lda, ldb; };

struct StaticOrder {
    int nM, nN, nwg, G, c;
    __host__ __device__ void init(int M, int N, int G_, int c_) { nM = M / BM; nN = N / BM; nwg = nM * nN; G = G_; c = c_; }
    __host__ __device__ bool next(int i, Unit& u) const {
        const long L = (long)i * G + c; if (L >= nwg) return false;
        int wgid = (int)L; { const int q = nwg / NXCD, r = nwg % NXCD, xcd = wgid % NXCD, off = wgid / NXCD; wgid = (xcd < r ? xcd * (q + 1) : r * (q + 1) + (xcd - r) * q) + off; }
        const int nig = WGM * nN, gid = wgid / nig, fm = gid * WGM, gsz = (nM - fm) < WGM ? (nM - fm) : WGM;
        u.pm = fm + ((wgid % nig) % gsz); u.pn = (wgid % nig) / gsz; return true;
    }
    __device__ __forceinline__ void a_ready(const Unit&) const {}
    __device__ __forceinline__ void done(const Unit&) const {}
};

__device__ __forceinline__ unsigned cvt_pk_bf16(float lo, float hi) { unsigned r; asm volatile("v_cvt_pk_bf16_f32 %0, %1, %2" : "=v"(r) : "v"(lo), "v"(hi)); return r; }
template <class Epi, class Sched, bool ALIGN_EPI = false, bool SP2 = false>
__device__ __forceinline__ void gemm_phase(PG8_LAS unsigned char* lds, const Gemm g, const Sched& S, const Epi& E) {
    const int tid = threadIdx.x, wid = __builtin_amdgcn_readfirstlane(tid >> 6), lane = tid & 63, wr = wid >> 2, wc = wid & 3, fr = lane & 15, fq = lane >> 4;
    const int K = g.K, nt = K / BK;
    unsigned voffA[2], voffB[2];
#pragma unroll
    for (int i = 0; i < 2; ++i) { int R, C; stage_rc(tid * 16 + i * 8192, R, C); const int Rb = Epi::PERM ? ((R & ~31) + perm32(R & 31)) : R;
        voffA[i] = (unsigned)(R * g.lda + C) * 2u; voffB[i] = (unsigned)(Rb * g.ldb + C) * 2u; }
    const size_t kstep = (size_t)(BK * 2);
    const size_t hstepA = (size_t)HALF * g.lda * 2, hstepB = (size_t)HALF * g.ldb * 2;
    const size_t tstepA = 2 * hstepA, tstepB = 2 * hstepB;
    const unsigned ldsw = (unsigned)wid * 1024u;
    const int aoff = lds_byte(wr * 64 + fr, fq * 8), boff = lds_byte(wc * 32 + fr, fq * 8);
#define PG8_SA(b, h) (((b) * 2 + (h)) * HTB)
#define PG8_SB(b, h) ((4 + (b) * 2 + (h)) * HTB)
#define PG8_STAGE(bufoff, gbase, voff) do { _Pragma("unroll") for (int _i = 0; _i < 2; ++_i) \
        __builtin_amdgcn_global_load_lds((const unsigned*)((const char*)(gbase) + (voff)[_i]), (PG8_LAS unsigned*)(lds + (bufoff) + ldsw + _i * 8192), 16, 0, 0); } while (0)
#define PG8_LDA(dst, b, h) do { _Pragma("unroll") for (int m = 0; m < 4; ++m) _Pragma("unroll") for (int k = 0; k < 2; ++k) dst[m][k] = *(const PG8_LAS bf16x8*)(lds + PG8_SA(b, h) + aoff + m * 2048 + k * 1024); } while (0)
#define PG8_LDB(dst, b, h) do { _Pragma("unroll") for (int n = 0; n < 2; ++n) _Pragma("unroll") for (int k = 0; k < 2; ++k) dst[n][k] = *(const PG8_LAS bf16x8*)(lds + PG8_SB(b, h) + boff + n * 2048 + k * 1024); } while (0)
#define PG8_MMA(ai, bj, At, Bt) do { __builtin_amdgcn_s_setprio(1); _Pragma("unroll") for (int m = 0; m < 4; ++m) _Pragma("unroll") for (int n = 0; n < 2; ++n) _Pragma("unroll") for (int k = 0; k < 2; ++k) \
        acc[ai][bj][m][n] = __builtin_amdgcn_mfma_f32_16x16x32_bf16(Bt[n][k], At[m][k], acc[ai][bj][m][n], 0, 0, 0); __builtin_amdgcn_s_setprio(0); } while (0)
#define PG8_WAIT_V(n) asm volatile("s_waitcnt vmcnt(" #n ")" ::: "memory")
#define PG8_WAIT_L(n) asm volatile("s_waitcnt lgkmcnt(" #n ")" ::: "memory")
#define PG8_BAR __builtin_amdgcn_s_barrier()
#define PG8_SCHED __builtin_amdgcn_sched_barrier(0)
    Unit cur, nxt; int ui = 0;
    if (!S.next(0, cur)) return;
    f32x4 acc[2][2][4][2];
#pragma unroll
    for (int a = 0; a < 2; ++a)
#pragma unroll
        for (int b = 0; b < 2; ++b)
#pragma unroll
            for (int m = 0; m < 4; ++m)
#pragma unroll
                for (int n = 0; n < 2; ++n) acc[a][b][m][n] = (f32x4){0.f, 0.f, 0.f, 0.f};
    bf16x8 At[4][2], B0[2][2], B1[2][2];
    const char* cA = (const char*)g.A + (size_t)cur.pm * tstepA; const char* cB = (const char*)g.Bt + (size_t)cur.pn * tstepB;
    S.a_ready(cur);
    if constexpr (SP2) {
        PG8_STAGE(PG8_SB(0, 0), cB, voffB); PG8_STAGE(PG8_SB(0, 1), cB + hstepB, voffB); PG8_STAGE(PG8_SA(0, 0), cA, voffA); PG8_STAGE(PG8_SA(0, 1), cA + hstepA, voffA);
        if (wr == 1) PG8_BAR;
        PG8_WAIT_V(2); PG8_BAR;
        PG8_STAGE(PG8_SB(1, 0), cB + kstep, voffB); PG8_STAGE(PG8_SA(1, 0), cA + kstep, voffA); PG8_STAGE(PG8_SB(1, 1), cB + hstepB + kstep, voffB);
        PG8_WAIT_V(6); PG8_BAR;
    } else {
        PG8_STAGE(PG8_SB(0, 0), cB, voffB); PG8_STAGE(PG8_SA(0, 0), cA, voffA); PG8_STAGE(PG8_SB(0, 1), cB + hstepB, voffB); PG8_STAGE(PG8_SA(0, 1), cA + hstepA, voffA);
        if (wr == 1) PG8_BAR;
        PG8_WAIT_V(4); PG8_BAR;
        PG8_STAGE(PG8_SB(1, 0), cB + kstep, voffB); PG8_STAGE(PG8_SA(1, 0), cA + kstep, voffA); PG8_STAGE(PG8_SB(1, 1), cB + hstepB + kstep, voffB);
        PG8_WAIT_V(6); PG8_BAR;
    }
    for (;;) {
        const bool has_next = S.next(ui + 1, nxt);
        const char* nA = has_next ? (const char*)g.A + (size_t)nxt.pm * tstepA : cA; const char* nB = has_next ? (const char*)g.Bt + (size_t)nxt.pn * tstepB : cB;
        for (int t = 0; t < nt; t += 2) {
            const bool last = (t == nt - 2);
            const char* a1 = cA + (size_t)(t + 1) * kstep;
            const char* a2 = last ? nA : cA + (size_t)(t + 2) * kstep; const char* b2 = last ? nB : cB + (size_t)(t + 2) * kstep;
            const char* a3 = a2 + kstep; const char* b3 = b2 + kstep;
            if (last && has_next) S.a_ready(nxt);
            if constexpr (SP2) {
            PG8_LDB(B0, 0, 0); PG8_LDB(B1, 0, 1); PG8_SCHED; PG8_LDA(At, 0, 0); PG8_STAGE(PG8_SA(1, 1), a1 + hstepA, voffA);
            PG8_WAIT_V(8); PG8_WAIT_L(0); PG8_BAR; PG8_MMA(0, 0, At, B0); PG8_MMA(0, 1, At, B1); PG8_BAR; PG8_SCHED;
            PG8_LDA(At, 0, 1); PG8_STAGE(PG8_SB(0, 0), b2, voffB); PG8_STAGE(PG8_SB(0, 1), b2 + hstepB, voffB); PG8_STAGE(PG8_SA(0, 0), a2, voffA);
            PG8_WAIT_V(8); PG8_WAIT_L(0); PG8_BAR; PG8_MMA(1, 0, At, B0); PG8_MMA(1, 1, At, B1); PG8_BAR; PG8_SCHED;
            PG8_LDB(B0, 1, 0); PG8_LDB(B1, 1, 1); PG8_SCHED; PG8_LDA(At, 1, 0); PG8_STAGE(PG8_SA(0, 1), a2 + hstepA, voffA);
            PG8_WAIT_V(8); PG8_WAIT_L(0); PG8_BAR; PG8_MMA(0, 0, At, B0); PG8_MMA(0, 1, At, B1); PG8_BAR; PG8_SCHED;
            PG8_LDA(At, 1, 1); PG8_STAGE(PG8_SB(1, 0), b3, voffB); PG8_STAGE(PG8_SB(1, 1), b3 + hstepB, voffB); PG8_STAGE(PG8_SA(1, 0), a3, voffA);
            PG8_WAIT_V(8); PG8_WAIT_L(0); PG8_BAR; PG8_MMA(1, 0, At, B0); PG8_MMA(1, 1, At, B1); PG8_BAR; PG8_SCHED;
            } else {
            PG8_LDB(B0, 0, 0); PG8_SCHED; PG8_LDA(At, 0, 0); PG8_STAGE(PG8_SA(1, 1), a1 + hstepA, voffA);
            PG8_WAIT_L(8); PG8_BAR; PG8_WAIT_L(0); PG8_MMA(0, 0, At, B0); PG8_BAR; PG8_SCHED;
            PG8_LDB(B1, 0, 1); PG8_STAGE(PG8_SB(0, 0), b2, voffB);
            PG8_BAR; PG8_WAIT_L(0); PG8_MMA(0, 1, At, B1); PG8_BAR;
            PG8_LDA(At, 0, 1); PG8_STAGE(PG8_SA(0, 0), a2, voffA);
            PG8_BAR; PG8_WAIT_L(0); PG8_MMA(1, 0, At, B0); PG8_BAR; PG8_SCHED;
            PG8_STAGE(PG8_SB(0, 1), b2 + hstepB, voffB);
            PG8_WAIT_V(6); PG8_BAR; PG8_MMA(1, 1, At, B1); PG8_BAR;
            PG8_LDB(B0, 1, 0); PG8_SCHED; PG8_LDA(At, 1, 0); PG8_STAGE(PG8_SA(0, 1), a2 + hstepA, voffA);
            PG8_WAIT_L(8); PG8_BAR; PG8_WAIT_L(0); PG8_MMA(0, 0, At, B0); PG8_BAR; PG8_SCHED;
            PG8_LDB(B1, 1, 1); PG8_STAGE(PG8_SB(1, 0), b3, voffB);
            PG8_BAR; PG8_WAIT_L(0); PG8_MMA(0, 1, At, B1); PG8_BAR;
            PG8_LDA(At, 1, 1); PG8_STAGE(PG8_SA(1, 0), a3, voffA);
            PG8_BAR; PG8_WAIT_L(0); PG8_MMA(1, 0, At, B0); PG8_BAR; PG8_SCHED;
            PG8_STAGE(PG8_SB(1, 1), b3 + hstepB, voffB);
            PG8_WAIT_V(6); PG8_BAR; PG8_MMA(1, 1, At, B1); PG8_BAR;
            }
        }
        if constexpr (ALIGN_EPI) { if (wr == 0) PG8_BAR; }
        if constexpr (!Epi::AFTER_DRAIN) { E(acc, cur, wr, wc, fr, fq); S.done(cur); }
        if (!has_next) break;
#pragma unroll
        for (int a = 0; a < 2; ++a)
#pragma unroll
            for (int b = 0; b < 2; ++b)
#pragma unroll
                for (int m = 0; m < 4; ++m)
#pragma unroll
                    for (int n = 0; n < 2; ++n) acc[a][b][m][n] = (f32x4){0.f, 0.f, 0.f, 0.f};
        cur = nxt; cA = nA; cB = nB; ++ui;
        if constexpr (ALIGN_EPI) { if (wr == 1) PG8_BAR; }
    }
    PG8_WAIT_V(0);
    if constexpr (!ALIGN_EPI) { if (wr == 0) PG8_BAR; }
    PG8_BAR;
    if constexpr (Epi::AFTER_DRAIN) { E.fused(acc, cur, wr, wc, fr, fq, lds, wid, lane); S.done(cur); }
#undef PG8_SA
#undef PG8_SB
#undef PG8_STAGE
#undef PG8_LDA
#undef PG8_LDB
#undef PG8_MMA
#undef PG8_WAIT_V
#undef PG8_WAIT_L
#undef PG8_BAR
#undef PG8_SCHED
}
}
#define DBG_SOLVE 0
#define NPHASE_STEPS 11
#define PROGRAM_STEPS STEP(0, 0) STEP(1, 1) STEP(2, 2) STEP(3, 3) STEP(4, 4) STEP(5, 5) STEP(6, 6) STEP(7, 7) STEP(8, 8) STEP(9, 10) STEP(10, 11)
typedef unsigned short bf16;
typedef short bf16x8 __attribute__((ext_vector_type(8)));
typedef short bf16x4 __attribute__((ext_vector_type(4)));
typedef float f32x4 __attribute__((ext_vector_type(4)));
typedef float f32x2 __attribute__((ext_vector_type(2)));
typedef unsigned u32x4 __attribute__((ext_vector_type(4)));
typedef unsigned u32x2 __attribute__((ext_vector_type(2)));

constexpr int NB = 4, T = 4096, D = 1024, M = NB * T, H = 8, CH = 128, NCH = T / CH;
constexpr int DFF = 2816, NUP = 2 * DFF;
constexpr int N1 = 5120, N5 = 4096, NIN = 9216, DIN = 9232;
constexpr float EPS = 1e-6f, GN_EPS = 1e-5f;
constexpr size_t MiB = 1u << 20;
constexpr size_t WS_CTL = 0, CTL_BYTES = 16384;
constexpr size_t WS_R1 = MiB / 4, WS_GB = MiB / 2, WS_SS1 = 3 * MiB / 2, WS_SS2 = 5 * MiB / 2, WS_ROPE = 7 * MiB / 2, WS_GC = 9 * MiB / 2, WS_HALO = 5 * MiB;
constexpr size_t WS_WIN = 8 * MiB;
constexpr size_t WS_KV = 16 * MiB, WS_UX = 32 * MiB, WS_H1B = 32 * MiB;
constexpr size_t WS_RQ = 64 * MiB, WS_RK = 80 * MiB, WS_RV = 96 * MiB, WS_DQ = 128 * MiB, WS_DK = 160 * MiB, WS_DV = 192 * MiB;
constexpr size_t WS_SN = 224 * MiB;
constexpr size_t WS_WRET = 224 * MiB, WS_WDN = 226 * MiB, WS_WO = 228 * MiB, WS_WUP = 230 * MiB, WS_WDOWN = 241 * MiB;
constexpr size_t WS_ACT = 64 * MiB, WS_HBUF = 152 * MiB, WS_END = 256 * MiB;
constexpr size_t OUT_W = 0, OUT_KDT = 32 * MiB;
constexpr int LDS_BYTES = 147456;
#ifndef NPHASE_STEPS
#define NPHASE_STEPS 11
#endif
constexpr int NPHASE = NPHASE_STEPS;

#ifndef N_LAUNCH_MODE
#define N_LAUNCH_MODE 1
#endif

typedef __bf16 bf16x2n __attribute__((ext_vector_type(2)));
__device__ __forceinline__ unsigned pk2(float lo, float hi) { const f32x2 f = {lo, hi}; return __builtin_bit_cast(unsigned, __builtin_convertvector(f, bf16x2n)); }
__device__ __forceinline__ float bflo(unsigned u) { return __uint_as_float(u << 16); }
__device__ __forceinline__ float bfhi(unsigned u) { return __uint_as_float(u & 0xffff0000u); }
__device__ __forceinline__ float bf2f(bf16 h) { return __uint_as_float(((unsigned)h) << 16); }
__device__ __forceinline__ bf16 f2bf(float f) { return (bf16)(pk2(f, 0.f) & 0xffffu); }
__device__ __forceinline__ float silu_f(float x) { return x * __builtin_amdgcn_rcpf(1.f + __expf(-x)); }
__device__ __forceinline__ float sigm_f(float x) { return __builtin_amdgcn_rcpf(1.f + __expf(-x)); }
__device__ __forceinline__ f32x4 mfma32(bf16x8 a, bf16x8 b, f32x4 c) { return __builtin_amdgcn_mfma_f32_16x16x32_bf16(a, b, c, 0, 0, 0); }
__device__ __forceinline__ f32x4 mfma16(bf16x4 a, bf16x4 b, f32x4 c) { return __builtin_amdgcn_mfma_f32_16x16x16bf16_1k(a, b, c, 0, 0, 0); }
__device__ __forceinline__ bf16x4 pack4(f32x4 v) { u32x2 w; w.x = pk2(v[0], v[1]); w.y = pk2(v[2], v[3]); return __builtin_bit_cast(bf16x4, w); }
__device__ __forceinline__ u32x4 pack8(f32x4 a, f32x4 b) { u32x4 w; w.x = pk2(a[0], a[1]); w.y = pk2(a[2], a[3]); w.z = pk2(b[0], b[1]); w.w = pk2(b[2], b[3]); return w; }
__device__ __forceinline__ void unpack8(u32x4 w, f32x4& a, f32x4& b) { a = (f32x4){bflo(w.x), bfhi(w.x), bflo(w.y), bfhi(w.y)}; b = (f32x4){bflo(w.z), bfhi(w.z), bflo(w.w), bfhi(w.w)}; }
#define LDSWAIT() asm volatile("s_waitcnt lgkmcnt(0)" ::: "memory")

struct Ctx {
    const float *x, *g_mix, *w_in, *ret_norm_g, *dn_conv_w, *dn_a_log, *dn_dt_bias, *dn_norm_g, *w_ret_br, *w_dn_br, *w_o, *g_ffn, *w_up, *ffn_conv_w, *ffn_conv_b, *w_down, *g_final;
    float* out; unsigned char* ws; unsigned char* lds;
    int tid, lane, wave, bid, G, fr, fq;
};

template <class F> struct EpiRow8 {
    static constexpr bool PERM = true, AFTER_DRAIN = false; F f;
    __device__ __forceinline__ void operator()(const pg8::f32x4 (&acc)[2][2][4][2], const pg8::Unit& u, int wr, int wc, int fr, int fq) const {
#pragma unroll
        for (int ai = 0; ai < 2; ++ai)
#pragma unroll
            for (int m = 0; m < 4; ++m) { const int row = u.pm * 256 + ai * 128 + wr * 64 + m * 16 + fr;
#pragma unroll
                for (int bj = 0; bj < 2; ++bj) { const int col = u.pn * 256 + bj * 128 + wc * 32 + 8 * fq; f(row, col, acc[ai][bj][m][0], acc[ai][bj][m][1]); } }
    }
};

struct F1 {
    const float* r1; const float* rope; bf16 *rq, *rk, *rv, *dqkv, *halo;
    __device__ __forceinline__ void operator()(int row, int col, f32x4 v0, f32x4 v1) const {
        const float r = r1[row]; v0 = v0 * r; v1 = v1 * r;
        if (col < 1024) {
            const int t = row & (T - 1), p0 = (col & 63) >> 1;
            const f32x4 cs0 = *(const f32x4*)(rope + ((size_t)t * 32 + p0) * 2), cs1 = *(const f32x4*)(rope + ((size_t)t * 32 + p0) * 2 + 4);
            const float sc = col >= 512 ? 0.125f : 1.f;
            f32x4 o0, o1;
            o0[0] = (v0[0] * cs0[0] - v0[1] * cs0[1]) * sc; o0[1] = (v0[0] * cs0[1] + v0[1] * cs0[0]) * sc;
            o0[2] = (v0[2] * cs0[2] - v0[3] * cs0[3]) * sc; o0[3] = (v0[2] * cs0[3] + v0[3] * cs0[2]) * sc;
            o1[0] = (v1[0] * cs1[0] - v1[1] * cs1[1]) * sc; o1[1] = (v1[0] * cs1[1] + v1[1] * cs1[0]) * sc;
            o1[2] = (v1[2] * cs1[2] - v1[3] * cs1[3]) * sc; o1[3] = (v1[2] * cs1[3] + v1[3] * cs1[2]) * sc;
            bf16* dst = (col < 512 ? rq : rk) + (size_t)row * 512 + (col & 511);
            *(u32x4*)dst = pack8(o0, o1);
        } else if (col < 2048) {
            *(u32x4*)(rv + (size_t)row * 1024 + (col - 1024)) = pack8(v0, v1);
        } else {
            const int cc = col - 2048; const u32x4 w = pack8(v0, v1);
            *(u32x4*)(dqkv + (size_t)(cc >> 10) * ((size_t)M * 1024) + (size_t)row * 1024 + (cc & 1023)) = w;
            if ((row & 127) >= 125) *(u32x4*)(halo + ((size_t)(row >> 7) * 3 + ((row & 127) - 125)) * 3072 + cc) = w;
        }
    }
};
struct F5 {
    const float* r1; bf16 *rv, *dv, *sigr, *sigd;
    __device__ __forceinline__ void operator()(int row, int col, f32x4 v0, f32x4 v1) const {
        const float r = r1[row]; v0 = v0 * r; v1 = v1 * r;
        const int t = col >> 10, cc = col & 1023;
        if (t < 2) {
            bf16* p = (t == 0 ? rv : dv) + (size_t)row * 1024 + cc; f32x4 a, b; unpack8(*(const u32x4*)p, a, b);
#pragma unroll
            for (int e = 0; e < 4; ++e) { a[e] *= silu_f(v0[e]); b[e] *= silu_f(v1[e]); }
            *(u32x4*)p = pack8(a, b);
        } else {
            bf16* p = (t == 2 ? sigr : sigd) + (size_t)row * 1024 + cc; f32x4 a, b;
#pragma unroll
            for (int e = 0; e < 4; ++e) { a[e] = sigm_f(v0[e]); b[e] = sigm_f(v1[e]); }
            *(u32x4*)p = pack8(a, b);
        }
    }
};
struct F6a { bf16* sigr;
    __device__ __forceinline__ void operator()(int row, int col, f32x4 v0, f32x4 v1) const {
        bf16* p = sigr + (size_t)row * 1024 + col; f32x4 a, b; unpack8(*(const u32x4*)p, a, b); a = a * v0; b = b * v1; *(u32x4*)p = pack8(a, b); }
};
struct F6b { bf16* sigr; const bf16* sigd;
    __device__ __forceinline__ void operator()(int row, int col, f32x4 v0, f32x4 v1) const {
        bf16* p = sigr + (size_t)row * 1024 + col; f32x4 a, b, s0, s1; unpack8(*(const u32x4*)p, a, b); unpack8(*(const u32x4*)(sigd + (size_t)row * 1024 + col), s0, s1);
        a = a + s0 * v0; b = b + s1 * v1; *(u32x4*)p = pack8(a, b); }
};
template <bool BASE_F32> struct EpiRes {
    static constexpr bool PERM = true, AFTER_DRAIN = false;
    const float* basef; bf16* hb; float* ss;
    __device__ __forceinline__ void operator()(const pg8::f32x4 (&acc)[2][2][4][2], const pg8::Unit& u, int wr, int wc, int fr, int fq) const {
#pragma unroll
        for (int ai = 0; ai < 2; ++ai)
#pragma unroll
            for (int m = 0; m < 4; ++m) { const int row = u.pm * 256 + ai * 128 + wr * 64 + m * 16 + fr; float ssq = 0.f;
#pragma unroll
                for (int bj = 0; bj < 2; ++bj) { const int col = u.pn * 256 + bj * 128 + wc * 32 + 8 * fq; const size_t off = (size_t)row * 1024 + col;
                    f32x4 b0, b1;
                    if (BASE_F32) { b0 = *(const f32x4*)(basef + off); b1 = *(const f32x4*)(basef + off + 4); } else unpack8(*(const u32x4*)(hb + off), b0, b1);
                    const f32x4 h0 = b0 + acc[ai][bj][m][0], h1 = b1 + acc[ai][bj][m][1];
                    *(u32x4*)(hb + off) = pack8(h0, h1);
                    ssq += (h0[0] * h0[0] + h0[1] * h0[1]) + (h0[2] * h0[2] + h0[3] * h0[3]) + (h1[0] * h1[0] + h1[1] * h1[1]) + (h1[2] * h1[2] + h1[3] * h1[3]); }
                ssq += __shfl_xor(ssq, 16); ssq += __shfl_xor(ssq, 32);
                if (fq == 0) ss[(size_t)row * 16 + u.pn * 4 + wc] = ssq; }
    }
};
__device__ __forceinline__ float dpp_ror1(float v) { return __builtin_bit_cast(float, __builtin_amdgcn_mov_dpp(__builtin_bit_cast(int, v), 0x121, 0xf, 0xf, false)); }
__device__ __forceinline__ float dpp_ror2(float v) { return __builtin_bit_cast(float, __builtin_amdgcn_mov_dpp(__builtin_bit_cast(int, v), 0x122, 0xf, 0xf, false)); }
struct Epi8 {
    static constexpr bool PERM = true, AFTER_DRAIN = false;
    const float* ss; bf16 *act, *hbuf; const float *cw, *cb;
    __device__ __forceinline__ void operator()(const pg8::f32x4 (&acc)[2][2][4][2], const pg8::Unit& u, int wr, int wc, int fr, int fq) const {
#pragma unroll
        for (int bj = 0; bj < 2; ++bj) {
            const int col = u.pn * 256 + bj * 128 + wc * 32 + 8 * fq, j0 = col >> 1;
            f32x4 W0[3], W1[3], B0, B1;
            { f32x4 wa[3], wb[3];
#pragma unroll
              for (int k = 0; k < 3; ++k) { wa[k] = *(const f32x4*)(cw + (size_t)k * NUP + j0); wb[k] = *(const f32x4*)(cw + (size_t)k * NUP + DFF + j0);
                  W0[k] = (f32x4){wa[k][0], wb[k][0], wa[k][1], wb[k][1]}; W1[k] = (f32x4){wa[k][2], wb[k][2], wa[k][3], wb[k][3]}; }
              const f32x4 ba = *(const f32x4*)(cb + j0), bb = *(const f32x4*)(cb + DFF + j0);
              B0 = (f32x4){ba[0], bb[0], ba[1], bb[1]}; B1 = (f32x4){ba[2], bb[2], ba[3], bb[3]}; }
#pragma unroll
            for (int ai = 0; ai < 2; ++ai) {
                f32x4 pv0 = (f32x4){0.f, 0.f, 0.f, 0.f}, pv1 = pv0;
#pragma unroll
                for (int m = 0; m < 4; ++m) {
                    const int row = u.pm * 256 + ai * 128 + wr * 64 + m * 16 + fr;
                    const f32x4* sp = (const f32x4*)(ss + (size_t)row * 16); const f32x4 s4 = (sp[0] + sp[1]) + (sp[2] + sp[3]);
                    const float rr = rsqrtf(((s4[0] + s4[1]) + (s4[2] + s4[3])) * (1.f / 1024.f) + EPS);
                    const f32x4 c0 = acc[ai][bj][m][0] * rr, c1 = acc[ai][bj][m][1] * rr;
                    f32x4 p10, p11, p20, p21;
#pragma unroll
                    for (int e = 0; e < 4; ++e) {
                        p10[e] = dpp_ror1(fr == 15 ? pv0[e] : c0[e]); p11[e] = dpp_ror1(fr == 15 ? pv1[e] : c1[e]);
                        p20[e] = dpp_ror2(fr >= 14 ? pv0[e] : c0[e]); p21[e] = dpp_ror2(fr >= 14 ? pv1[e] : c1[e]); }
                    const f32x4 y0 = W0[0] * p20 + W0[1] * p10 + W0[2] * c0 + B0, y1 = W1[0] * p21 + W1[1] * p11 + W1[2] * c1 + B1;
                    const f32x4 o = (f32x4){silu_f(y0[0]) * y0[1], silu_f(y0[2]) * y0[3], silu_f(y1[0]) * y1[1], silu_f(y1[2]) * y1[3]};
                    const bool head = (m == 0) && (fr < 2);
                    if (!head) *(bf16x4*)(act + (size_t)row * DFF + j0) = pack4(o);
                    if (head || (m == 3 && fr >= 14)) { const int slot = (m == 0) ? fr : (fr - 12);
                        *(u32x4*)(hbuf + ((size_t)(row >> 6) * 4 + slot) * NUP + col) = pack8(c0, c1); }
                    pv0 = c0; pv1 = c1;
                    asm volatile("" ::: "memory");
                }
            }
        }
    }
};

__device__ __forceinline__ int win_srccol_old(int n) {
    if (n < 1024) return (n & ~63) + ((n & 63) >> 1) + 32 * (n & 1);
    if (n < 2048) return n;
    if (n < 5120) return n + 1024;
    if (n < 6144) return n - 5120 + 2048;
    if (n < 7168) return n;
    return n + 16;
}
__device__ __forceinline__ int win_srccol(int n) { return win_srccol_old(n < N5 ? n + N1 : n - N5); }
template <int MAP> __device__ __forceinline__ void transpose_item(const float* W, int K, int N, bf16* WT, const float* gk, float* scr, int item, int nblk, int lane) {
    const int kb = item / nblk, nb = item % nblk, k0 = 64 * kb, n0 = 32 * nb;
    const int ng = lane & 7, kr = lane >> 3, np = n0 + 4 * ng;
    bool pair = false; int s0 = np, s1 = 0;
    if (MAP == 2) { pair = true; s0 = np >> 1; s1 = s0 + DFF; }
    if (MAP == 1) { const int o = np < N5 ? np + N1 : np - N5; if (o < 1024) { pair = true; s0 = (o & ~63) + ((o & 63) >> 1); s1 = s0 + 32; } else s0 = win_srccol_old(o); }
#pragma unroll
    for (int i = 0; i < 8; ++i) { const int kk = 8 * i + kr; const float* row = W + (size_t)(k0 + kk) * N; f32x4 v;
        if (pair) { const f32x2 p0 = *(const f32x2*)(row + s0), p1 = *(const f32x2*)(row + s1); v = (f32x4){p0[0], p1[0], p0[1], p1[1]}; }
        else v = *(const f32x4*)(row + s0);
        if (gk) v = v * gk[k0 + kk];
        float* d = scr + kk * 33 + 4 * ng; d[0] = v[0]; d[1] = v[1]; d[2] = v[2]; d[3] = v[3]; }
    LDSWAIT();
    const int c = lane & 7;
#pragma unroll
    for (int j = 0; j < 4; ++j) { const int n = (lane >> 3) + 8 * j; const float* s = scr + (8 * c) * 33 + n;
        u32x4 o; o.x = pk2(s[0 * 33], s[1 * 33]); o.y = pk2(s[2 * 33], s[3 * 33]); o.z = pk2(s[4 * 33], s[5 * 33]); o.w = pk2(s[6 * 33], s[7 * 33]);
        *(u32x4*)(WT + (size_t)(n0 + n) * K + k0 + 8 * c) = o; }
    LDSWAIT();
}
__device__ __forceinline__ void phase0(const Ctx& c) {
    float* scr = (float*)(c.lds + c.wave * 16384);
    const int gw = c.bid * 8 + c.wave, ngw = c.G * 8;
    constexpr int I_IN = 16 * (NIN / 32);
    for (int it = gw; it < I_IN; it += ngw) transpose_item<1>(c.w_in, 1024, DIN, (bf16*)(c.ws + WS_WIN), nullptr, scr, it, NIN / 32, c.lane);
    float* rope = (float*)(c.ws + WS_ROPE);
    for (int i = c.bid * 512 + c.tid; i < T * 32; i += c.G * 512) { const int t = i >> 5, p = i & 31;
        const float inv = exp2f(-(float)p * 0.41524101186092029f); const float ang = (float)t * inv;
        const double rev = (double)ang * 0.15915494309189535; const float fr_ = (float)(rev - rint(rev));
        rope[2 * i] = __cosf(fr_ * 6.283185307179586f); rope[2 * i + 1] = __sinf(fr_ * 6.283185307179586f); }
    __syncthreads();
    bf16* wab = (bf16*)c.lds;
    for (int i = c.tid; i < 16 * 1024; i += 512) { const int n = i & 15, k = i >> 4; wab[n * 1032 + k] = f2bf(c.w_in[(size_t)k * DIN + 7168 + n]); }
    __syncthreads();
    bf16* Ux = (bf16*)(c.ws + WS_UX); float* r1 = (float*)(c.ws + WS_R1); float* gb = (float*)(c.ws + WS_GB);
    const int fr = c.fr, fq = c.fq;
    if ((c.wave & 1) == 0) for (int gi = c.bid * 4 + (c.wave >> 1); gi < M / 16; gi += c.G * 4) {
        const int row0 = gi * 16; const float* xr = c.x + (size_t)(row0 + fr) * 1024 + 8 * fq; bf16* ur = Ux + (size_t)(row0 + fr) * 1024 + 8 * fq;
        f32x4 acc = (f32x4){0.f, 0.f, 0.f, 0.f}; float ssq = 0.f;
#pragma unroll 8
        for (int kk = 0; kk < 32; ++kk) {
            f32x4 a0 = *(const f32x4*)(xr + 32 * kk), a1 = *(const f32x4*)(xr + 32 * kk + 4);
            const f32x4 g0 = *(const f32x4*)(c.g_mix + 32 * kk + 8 * fq), g1 = *(const f32x4*)(c.g_mix + 32 * kk + 8 * fq + 4);
            ssq += (a0[0] * a0[0] + a0[1] * a0[1]) + (a0[2] * a0[2] + a0[3] * a0[3]) + (a1[0] * a1[0] + a1[1] * a1[1]) + (a1[2] * a1[2] + a1[3] * a1[3]);
            a0 = a0 * g0; a1 = a1 * g1; const u32x4 pk = pack8(a0, a1);
            *(u32x4*)(ur + 32 * kk) = pk;
            const bf16x8 bfr = *(const bf16x8*)(wab + fr * 1032 + 32 * kk + 8 * fq);
            acc = mfma32(__builtin_bit_cast(bf16x8, pk), bfr, acc);
        }
        ssq += __shfl_xor(ssq, 16); ssq += __shfl_xor(ssq, 32);
        const float r = rsqrtf(ssq * (1.f / 1024.f) + EPS);
        if (fq == 0) r1[row0 + fr] = r;
#pragma unroll
        for (int j = 0; j < 4; ++j) { const float rj = __shfl(r, 4 * fq + j); const float val = acc[j] * rj; const int row = row0 + 4 * fq + j; float o;
            if (fr < 8) o = sigm_f(val);
            else { const int hh = fr - 8; const float z = val + c.dn_dt_bias[hh]; const float sp = z > 20.f ? z : log1pf(expf(z)); o = -expf(c.dn_a_log[hh]) * sp; }
            gb[(size_t)row * 16 + fr] = o; }
    }
}

constexpr int L_KS = 0, L_KT = 34816, L_VT = 68608, L_AB = 102400, L_TII = 137216, L_G = 141312;
__device__ __forceinline__ void dn_prep(const Ctx& c, int id) {
    const int bh = id >> 5, n = id & 31, b = bh >> 3, h = bh & 7, rowbase = b * T + n * CH;
    const int tid = c.tid, fr = c.fr, fq = c.fq, w = c.wave;
    bf16* ks = (bf16*)(c.lds + L_KS); bf16* kT = (bf16*)(c.lds + L_KT); bf16* vT = (bf16*)(c.lds + L_VT); bf16* Ab = (bf16*)(c.lds + L_AB); bf16* Tii = (bf16*)(c.lds + L_TII);
    float* Gs = (float*)(c.lds + L_G); float* Bs = Gs + 128; float* graw = Gs + 256;
    const float* gb = (const float*)(c.ws + WS_GB); float* Gc = (float*)(c.ws + WS_GC);
    bf16* dqkv = (bf16*)(c.ws + WS_DQ); const bf16* halo = (const bf16*)(c.ws + WS_HALO);
    if (tid < 128) { graw[tid] = gb[(size_t)(rowbase + tid) * 16 + 8 + h]; Bs[tid] = gb[(size_t)(rowbase + tid) * 16 + h]; }
    __syncthreads();
    if (tid < 128) {
        float s = graw[tid];
#pragma unroll
        for (int o = 1; o < 64; o <<= 1) { const float t = __shfl_up(s, o); if (c.lane >= o) s += t; }
        if (tid >= 64) { float tot = 0.f;
#pragma unroll 8
            for (int t = 0; t < 64; t += 4) { const f32x4 g4 = *(const f32x4*)(graw + t); tot += (g4[0] + g4[1]) + (g4[2] + g4[3]); }
            s += tot; }
        Gs[tid] = s; Gc[(size_t)id * 128 + tid] = s; }
    const int i = tid >> 2, cg = tid & 3;
    bf16* qs = Ab;
#ifndef DP_SKIP_CONV
    {
        const int cgp = tid & 15, strip = tid >> 4, col8 = 8 * cgp, i4 = 4 * strip;
#pragma unroll 1
        for (int t = 1; t < 3; ++t) {
            u32x4 raw[7];
#pragma unroll
            for (int k = 0; k < 7; ++k) { const int rr = i4 - 3 + k; u32x4 r = (u32x4){0u, 0u, 0u, 0u};
                if (rr >= 0) r = *(const u32x4*)(dqkv + (size_t)t * ((size_t)M * 1024) + (size_t)(rowbase + rr) * 1024 + h * 128 + col8);
                else if (n > 0) r = *(const u32x4*)(halo + ((size_t)(b * 32 + n - 1) * 3 + (rr + 3)) * 3072 + t * 1024 + h * 128 + col8);
                raw[k] = r; }
            f32x4 w0[4], w1[4];
#pragma unroll
            for (int k = 0; k < 4; ++k) { const float* wp = c.dn_conv_w + (size_t)k * 3072 + t * 1024 + h * 128 + col8; w0[k] = *(const f32x4*)wp; w1[k] = *(const f32x4*)(wp + 4); }
            f32x4 y0[4], y1[4]; float ssq[4];
#pragma unroll
            for (int r = 0; r < 4; ++r) { f32x4 a0 = (f32x4){0.f, 0.f, 0.f, 0.f}, a1 = a0;
#pragma unroll
                for (int k = 0; k < 4; ++k) { f32x4 x0, x1; unpack8(raw[r + k], x0, x1); a0 = a0 + x0 * w0[k]; a1 = a1 + x1 * w1[k]; }
                float sq = 0.f;
#pragma unroll
                for (int e = 0; e < 4; ++e) { a0[e] = silu_f(a0[e]); a1[e] = silu_f(a1[e]); sq += a0[e] * a0[e] + a1[e] * a1[e]; }
                y0[r] = a0; y1[r] = a1; ssq[r] = sq; }
            if (t < 2) {
#pragma unroll
                for (int r = 0; r < 4; ++r) { float sq = ssq[r]; sq += __shfl_xor(sq, 1); sq += __shfl_xor(sq, 2); sq += __shfl_xor(sq, 4); sq += __shfl_xor(sq, 8);
                    const float rn = rsqrtf(sq + EPS); y0[r] = y0[r] * rn; y1[r] = y1[r] * rn; }
            }
            u32x4 p[4];
#pragma unroll
            for (int r = 0; r < 4; ++r) p[r] = pack8(y0[r], y1[r]);
            if (t == 0) {
#pragma unroll
                for (int r = 0; r < 4; ++r) *(u32x4*)(qs + (i4 + r) * 136 + col8) = p[r];
            } else {
                if (t == 1) {
#pragma unroll
                    for (int r = 0; r < 4; ++r) *(u32x4*)(ks + (i4 + r) * 136 + col8) = p[r];
                }
                bf16* dT = (t == 1) ? kT : vT;
                const unsigned pw[4][4] = {{p[0].x, p[0].y, p[0].z, p[0].w}, {p[1].x, p[1].y, p[1].z, p[1].w}, {p[2].x, p[2].y, p[2].z, p[2].w}, {p[3].x, p[3].y, p[3].z, p[3].w}};
#pragma unroll
                for (int e = 0; e < 4; ++e) {
                    u32x2 lo, hi;
                    lo.x = (pw[0][e] & 0xffffu) | (pw[1][e] << 16); lo.y = (pw[2][e] & 0xffffu) | (pw[3][e] << 16);
                    hi.x = (pw[0][e] >> 16) | (pw[1][e] & 0xffff0000u); hi.y = (pw[2][e] >> 16) | (pw[3][e] & 0xffff0000u);
                    *(u32x2*)(dT + (col8 + 2 * e) * 132 + i4) = lo; *(u32x2*)(dT + (col8 + 2 * e + 1) * 132 + i4) = hi;
                }
            }
        }
    }
#endif
    __syncthreads();
#pragma unroll
    for (int s4 = 0; s4 < 4; ++s4) { const int idx = tid + 512 * s4, r = idx >> 4, c8 = (idx & 15) * 8;
        *(u32x4*)(dqkv + (size_t)M * 1024 + (size_t)(rowbase + r) * 1024 + h * 128 + c8) = *(const u32x4*)(ks + r * 136 + c8);
    }
    __syncthreads();
#ifndef DP_SKIP_KK
    {
        const int i0 = 16 * w; bf16x8 ai[4];
#pragma unroll
        for (int kk = 0; kk < 4; ++kk) ai[kk] = *(const bf16x8*)(ks + (i0 + fr) * 136 + 32 * kk + 8 * fq);
        const float Gi = Gs[i0 + fr], bi_ = Bs[i0 + fr];
        for (int jt = 0; jt <= w; ++jt) {
            f32x4 acc = (f32x4){0.f, 0.f, 0.f, 0.f};
#pragma unroll
            for (int kk = 0; kk < 4; ++kk) acc = mfma32(*(const bf16x8*)(ks + (16 * jt + fr) * 136 + 32 * kk + 8 * fq), ai[kk], acc);
            const f32x4 G4 = *(const f32x4*)(Gs + 16 * jt + 4 * fq); f32x4 o;
#pragma unroll
            for (int r = 0; r < 4; ++r) { const int j = 16 * jt + 4 * fq + r; o[r] = (i0 + fr > j) ? -bi_ * acc[r] * __expf(Gi - G4[r]) : 0.f; }
            *(bf16x4*)(Ab + (i0 + fr) * 136 + 16 * jt + 4 * fq) = pack4(o);
        }
    }
#endif
    __syncthreads();
#ifndef DP_SKIP_TII
    if (tid < 128) {
        const int blk = tid >> 4, cx = tid & 15; float xs[16];
#pragma unroll
        for (int r = 0; r < 16; ++r) {
            float s = (r == cx) ? 1.f : 0.f;
            const u32x4 ra = *(const u32x4*)(Ab + (16 * blk + r) * 136 + 16 * blk), rb = *(const u32x4*)(Ab + (16 * blk + r) * 136 + 16 * blk + 8);
            const unsigned rw[8] = {ra.x, ra.y, ra.z, ra.w, rb.x, rb.y, rb.z, rb.w};
#pragma unroll
            for (int s_ = 0; s_ < r; ++s_) { const float av = (s_ & 1) ? bfhi(rw[s_ >> 1]) : bflo(rw[s_ >> 1]); s += av * xs[s_]; }
            xs[r] = s; Tii[(blk * 16 + r) * 16 + cx] = f2bf(s);
            asm volatile("" ::: "memory");
        }
    }
#endif
#ifndef DP_SKIP_KD
    {
        const int d = tid >> 2, ig = tid & 3; const float Gl = Gs[127]; bf16* dst = (bf16*)(c.out) + (OUT_KDT / 2) + (size_t)id * 16384 + (size_t)((((d >> 4) * 4 + ig) * 64) + (d & 15)) * 8;
#pragma unroll
        for (int q = 0; q < 4; ++q) {
            const u32x2 r0 = *(const u32x2*)(kT + d * 132 + 32 * ig + 8 * q), r1 = *(const u32x2*)(kT + d * 132 + 32 * ig + 8 * q + 4);
            const f32x4 g0 = *(const f32x4*)(Gs + 32 * ig + 8 * q), g1 = *(const f32x4*)(Gs + 32 * ig + 8 * q + 4);
            f32x4 a = (f32x4){bflo(r0.x), bfhi(r0.x), bflo(r0.y), bfhi(r0.y)}, bb = (f32x4){bflo(r1.x), bfhi(r1.x), bflo(r1.y), bfhi(r1.y)};
#pragma unroll
            for (int e = 0; e < 4; ++e) { a[e] *= __expf(Gl - g0[e]); bb[e] *= __expf(Gl - g1[e]); }
            *(u32x4*)(dst + 128 * q) = pack8(a, bb);
        }
    }
#endif
    __syncthreads();
#ifndef DP_SKIP_SOLVE
    {
        const bool isk = w >= 4; const bf16* srcT = isk ? kT : vT; const int cb = (w & 3) * 32;
        bf16x4 X[8][2];
#pragma unroll
        for (int bi = 0; bi < 8; ++bi) {
            f32x4 bet = *(const f32x4*)(Bs + 16 * bi + 4 * fq);
            if (isk) { const f32x4 g4 = *(const f32x4*)(Gs + 16 * bi + 4 * fq); bet[0] *= __expf(g4[0]); bet[1] *= __expf(g4[1]); bet[2] *= __expf(g4[2]); bet[3] *= __expf(g4[3]); }
            f32x4 acc[2];
#pragma unroll
            for (int t = 0; t < 2; ++t) { const u32x2 raw = *(const u32x2*)(srcT + (cb + 16 * t + fr) * 132 + 16 * bi + 4 * fq);
                acc[t] = (f32x4){bflo(raw.x) * bet[0], bfhi(raw.x) * bet[1], bflo(raw.y) * bet[2], bfhi(raw.y) * bet[3]}; }
#pragma unroll
            for (int kb = 0; kb < ((DBG_SOLVE == 2 || DBG_SOLVE == 3) ? 0 : bi); ++kb) { const bf16x4 af = *(const bf16x4*)(Ab + (16 * bi + fr) * 136 + 16 * kb + 4 * fq);
                acc[0] = mfma16(af, X[kb][0], acc[0]); acc[1] = mfma16(af, X[kb][1], acc[1]); }
            const bf16x4 tf = *(const bf16x4*)(Tii + (bi * 16 + fr) * 16 + 4 * fq);
#pragma unroll
#if DBG_SOLVE == 1 || DBG_SOLVE == 3
            for (int t = 0; t < 2; ++t) X[bi][t] = pack4(acc[t]);
#else
            for (int t = 0; t < 2; ++t) X[bi][t] = pack4(mfma16(tf, pack4(acc[t]), (f32x4){0.f, 0.f, 0.f, 0.f}));
#endif
            asm volatile("" ::: "memory");
        }
        if (!isk) {
            bf16* dvp = (bf16*)(c.ws + WS_DV);
#pragma unroll
            for (int bi = 0; bi < 8; ++bi)
#pragma unroll
                for (int t = 0; t < 2; ++t) { const int cc = cb + 16 * t + fr, o = (((cc >> 4) * 8 + bi) * 16 + (cc & 15)) * 16 + 4 * fq;
                    *(bf16x4*)(dvp + (size_t)(rowbase + (o >> 7)) * 1024 + h * 128 + (o & 127)) = X[bi][t]; }
        } else {
#pragma unroll
            for (int bi = 0; bi < 8; ++bi)
#pragma unroll
                for (int t = 0; t < 2; ++t) { const u32x2 xx = __builtin_bit_cast(u32x2, X[bi][t]); const int col = cb + 16 * t + fr, r0 = 16 * bi + 4 * fq;
                    ks[(r0 + 0) * 136 + col] = (bf16)(xx.x & 0xffffu); ks[(r0 + 1) * 136 + col] = (bf16)(xx.x >> 16);
                    ks[(r0 + 2) * 136 + col] = (bf16)(xx.y & 0xffffu); ks[(r0 + 3) * 136 + col] = (bf16)(xx.y >> 16); }
        }
    }
#endif
    __syncthreads();
    {
        const int ii = tid >> 2, dg = tid & 3; bf16* dst = (bf16*)(c.out) + (OUT_W / 2) + (size_t)id * 16384 + (size_t)((((ii >> 4) * 4 + dg) * 64) + (ii & 15)) * 8;
#pragma unroll
        for (int q = 0; q < 4; ++q) *(u32x4*)(dst + 128 * q) = *(const u32x4*)(ks + ii * 136 + 32 * dg + 8 * q);
    }
    __syncthreads();
}
__device__ __forceinline__ void strip_transpose_store(bf16* dT, int ld, int c8, int j4, const u32x4 (&p)[4]) {
    const unsigned pw[4][4] = {{p[0].x, p[0].y, p[0].z, p[0].w}, {p[1].x, p[1].y, p[1].z, p[1].w}, {p[2].x, p[2].y, p[2].z, p[2].w}, {p[3].x, p[3].y, p[3].z, p[3].w}};
#pragma unroll
    for (int e = 0; e < 4; ++e) { u32x2 lo, hi;
        lo.x = (pw[0][e] & 0xffffu) | (pw[1][e] << 16); lo.y = (pw[2][e] & 0xffffu) | (pw[3][e] << 16);
        hi.x = (pw[0][e] >> 16) | (pw[1][e] & 0xffff0000u); hi.y = (pw[2][e] >> 16) | (pw[3][e] & 0xffff0000u);
        *(u32x2*)(dT + (c8 + 2 * e) * ld + j4) = lo; *(u32x2*)(dT + (c8 + 2 * e + 1) * ld + j4) = hi; }
}
__device__ __forceinline__ float ret_logg(int h) { return log1pf(-exp2f(-5.f - (float)h)); }
__device__ __forceinline__ void ret_kv(const Ctx& c, int id) {
    const int bh = id >> 5, n = id & 31, b = bh >> 3, h = bh & 7, rowbase = b * T + n * CH;
    const int tid = c.tid, fr = c.fr, fq = c.fq, w = c.wave;
    bf16* kT2 = (bf16*)c.lds; bf16* vT2 = (bf16*)(c.lds + 17408);
    const bf16* rk = (const bf16*)(c.ws + WS_RK); const bf16* rv = (const bf16*)(c.ws + WS_RV);
    const float lg = ret_logg(h);
    { const int c8 = 8 * (tid & 15), j4 = 4 * (tid >> 4); u32x4 p[4];
#pragma unroll
      for (int r = 0; r < 4; ++r) p[r] = *(const u32x4*)(rv + (size_t)(rowbase + j4 + r) * 1024 + h * 128 + c8);
      strip_transpose_store(vT2, 136, c8, j4, p); }
    if (tid < 256) { const int c8 = 8 * (tid & 7), j4 = 4 * (tid >> 3); u32x4 p[4];
#pragma unroll
      for (int r = 0; r < 4; ++r) { f32x4 a, bb; unpack8(*(const u32x4*)(rk + (size_t)(rowbase + j4 + r) * 512 + h * 64 + c8), a, bb); const float z = __expf(lg * (float)(127 - (j4 + r))); p[r] = pack8(a * z, bb * z); }
      strip_transpose_store(kT2, 136, c8, j4, p); }
    __syncthreads();
    bf16* kv = (bf16*)(c.ws + WS_KV) + (size_t)id * 8192;
#pragma unroll
    for (int dt = 0; dt < 4; ++dt) { f32x4 acc = (f32x4){0.f, 0.f, 0.f, 0.f};
#pragma unroll
        for (int kk = 0; kk < 4; ++kk) acc = mfma32(*(const bf16x8*)(kT2 + (16 * dt + fr) * 136 + 32 * kk + 8 * fq), *(const bf16x8*)(vT2 + (16 * w + fr) * 136 + 32 * kk + 8 * fq), acc);
        *(bf16x4*)(kv + (16 * w + fr) * 64 + 16 * dt + 4 * fq) = pack4(acc); }
    __syncthreads();
}

__device__ __forceinline__ void phase3(const Ctx& c) {
    const int fr = c.fr, fq = c.fq, w = c.wave, tid = c.tid;
    bf16* Sl = (bf16*)c.lds; bf16* Vl = (bf16*)(c.lds + 4352);
    const bf16* Wp0 = (const bf16*)(c.out) + (OUT_W / 2); const bf16* Kp0 = (const bf16*)(c.out) + (OUT_KDT / 2);
    bf16* dvp = (bf16*)(c.ws + WS_DV); bf16* snp = (bf16*)(c.ws + WS_SN); const float* Gc = (const float*)(c.ws + WS_GC);
    for (int wi = c.bid; wi < 256; wi += c.G) {
        const int xq = wi & 7, yq = wi >> 3, slice = yq & 7, bh = xq + 8 * (yq >> 3), b = bh >> 3, h = bh & 7;
        for (int i = tid; i < 16 * 136 / 2; i += 512) ((unsigned*)Sl)[i] = 0u;
        __syncthreads();
        f32x4 S = (f32x4){0.f, 0.f, 0.f, 0.f};
        const size_t woff = (size_t)w * 2048 + (size_t)c.lane * 8;
        const bf16* Wb = Wp0 + (size_t)(bh * 32) * 16384 + woff; const bf16* Kb = Kp0 + (size_t)(bh * 32) * 16384 + woff;
        const int o3 = ((slice * 8 + w) * 16 + fr) * 16 + 4 * fq;
        bf16* ub = dvp + (size_t)(b * T + (o3 >> 7)) * 1024 + h * 128 + (o3 & 127);
        bf16* sb = snp + (size_t)(bh * 32) * 16384 + o3;
        const float* gl = Gc + (size_t)(bh * 32) * 128 + 127;
        bf16x8 wR[4][4], kR[4][4]; bf16x4 uR[4]; float dR[4];
#define P3_LOAD(slot, n_) do { _Pragma("unroll") for (int kk = 0; kk < 4; ++kk) { wR[slot][kk] = *(const bf16x8*)(Wb + (size_t)(n_) * 16384 + 512 * kk); kR[slot][kk] = *(const bf16x8*)(Kb + (size_t)(n_) * 16384 + 512 * kk); } \
            uR[slot] = *(const bf16x4*)(ub + (size_t)(n_) * CH * 1024); dR[slot] = gl[(size_t)(n_) * 128]; } while (0)
#define P3_BAR() do { asm volatile("s_waitcnt lgkmcnt(0)" ::: "memory"); __builtin_amdgcn_s_barrier(); asm volatile("" ::: "memory"); } while (0)
#define P3_STEP(slot, n_) do { \
            *(bf16x4*)(sb + (size_t)(n_) * 16384) = pack4(S); \
            f32x4 accA = (f32x4){0.f, 0.f, 0.f, 0.f}, accB = accA; \
            accA = mfma32(wR[slot][0], *(const bf16x8*)(Sl + fr * 136 + 8 * fq), accA); accB = mfma32(wR[slot][1], *(const bf16x8*)(Sl + fr * 136 + 32 + 8 * fq), accB); \
            accA = mfma32(wR[slot][2], *(const bf16x8*)(Sl + fr * 136 + 64 + 8 * fq), accA); accB = mfma32(wR[slot][3], *(const bf16x8*)(Sl + fr * 136 + 96 + 8 * fq), accB); \
            const u32x2 ur = __builtin_bit_cast(u32x2, uR[slot]); \
            const f32x4 vn = (f32x4){bflo(ur.x) - (accA[0] + accB[0]), bfhi(ur.x) - (accA[1] + accB[1]), bflo(ur.y) - (accA[2] + accB[2]), bfhi(ur.y) - (accA[3] + accB[3])}; \
            const bf16x4 vb = pack4(vn); \
            *(bf16x4*)(ub + (size_t)(n_) * CH * 1024) = vb; \
            *(bf16x4*)(Vl + fr * 136 + 16 * w + 4 * fq) = vb; \
            P3_BAR(); \
            f32x4 acC = (f32x4){0.f, 0.f, 0.f, 0.f}, acD = acC; \
            acC = mfma32(kR[slot][0], *(const bf16x8*)(Vl + fr * 136 + 8 * fq), acC); acD = mfma32(kR[slot][1], *(const bf16x8*)(Vl + fr * 136 + 32 + 8 * fq), acD); \
            acC = mfma32(kR[slot][2], *(const bf16x8*)(Vl + fr * 136 + 64 + 8 * fq), acC); acD = mfma32(kR[slot][3], *(const bf16x8*)(Vl + fr * 136 + 96 + 8 * fq), acD); \
            S = S * __expf(dR[slot]) + (acC + acD); \
            *(bf16x4*)(Sl + fr * 136 + 16 * w + 4 * fq) = pack4(S); \
            P3_BAR(); } while (0)
        P3_LOAD(0, 0); P3_LOAD(1, 1); P3_LOAD(2, 2); P3_LOAD(3, 3);
#pragma unroll
        for (int n4 = 0; n4 < NCH; n4 += 4) {
            const int np = (n4 + 4 < NCH) ? 4 : 0;
            P3_STEP(0, n4);     P3_LOAD(0, n4 + np);
            P3_STEP(1, n4 + 1); P3_LOAD(1, n4 + np + (np ? 1 : 0));
            P3_STEP(2, n4 + 2); P3_LOAD(2, n4 + np + (np ? 2 : 0));
            P3_STEP(3, n4 + 3); P3_LOAD(3, n4 + np + (np ? 3 : 0));
        }
#undef P3_LOAD
#undef P3_STEP
#undef P3_BAR
        __syncthreads();
    }
    for (int gid = c.bid * 512 + tid; gid < 32 * 4096; gid += c.G * 512) {
        const int bh = gid >> 12, e = gid & 4095, h = bh & 7; const float decay = __expf(128.f * ret_logg(h));
        unsigned* p = (unsigned*)(c.ws + WS_KV) + (size_t)(bh * 32) * 4096 + e; float s0 = 0.f, s1 = 0.f;
#pragma unroll 8
        for (int n = 0; n < NCH; ++n) { const unsigned raw = p[(size_t)n * 4096]; p[(size_t)n * 4096] = pk2(s0, s1); s0 = s0 * decay + bflo(raw); s1 = s1 * decay + bfhi(raw); }
    }
}

struct DnPre { u32x4 kk[4], vv[4], ss[4], qraw[7]; float g; };
__device__ __forceinline__ void dn_out_load(const Ctx& c, int id, DnPre& p) {
    const int bh = id >> 5, n = id & 31, b = bh >> 3, h = bh & 7, rowbase = b * T + n * CH; const int tid = c.tid, fr = c.fr, fq = c.fq, w = c.wave;
    const bf16* dq = (const bf16*)(c.ws + WS_DQ); const bf16* dk = (const bf16*)(c.ws + WS_DK); const bf16* dv = (const bf16*)(c.ws + WS_DV); const bf16* sn = (const bf16*)(c.ws + WS_SN) + (size_t)id * 16384;
#pragma unroll
    for (int s = 0; s < 4; ++s) { const int idx = tid + 512 * s, r = idx >> 4, c8 = (idx & 15) * 8;
        const int o = 8 * idx;
        p.kk[s] = *(const u32x4*)(dk + (size_t)(rowbase + r) * 1024 + h * 128 + c8); p.vv[s] = *(const u32x4*)(dv + (size_t)(rowbase + (o >> 7)) * 1024 + h * 128 + (o & 127)); p.ss[s] = *(const u32x4*)(sn + o); }
    { const bf16* halo = (const bf16*)(c.ws + WS_HALO); const int col8 = 8 * (tid & 15), i4 = 4 * (tid >> 4);
#pragma unroll
      for (int k = 0; k < 7; ++k) { const int rr = i4 - 3 + k; u32x4 r = (u32x4){0u, 0u, 0u, 0u};
          if (rr >= 0) r = *(const u32x4*)(dq + (size_t)(rowbase + rr) * 1024 + h * 128 + col8);
          else if (n > 0) r = *(const u32x4*)(halo + ((size_t)(b * 32 + n - 1) * 3 + (rr + 3)) * 3072 + h * 128 + col8);
          p.qraw[k] = r; } }
    p.g = (tid < 128) ? ((const float*)(c.ws + WS_GC))[(size_t)id * 128 + tid] : 0.f;
}
__device__ __forceinline__ void dn_out(const Ctx& c, int id, int next_id, DnPre& p) {
    const int bh = id >> 5, n = id & 31, b = bh >> 3, h = bh & 7, rowbase = b * T + n * CH;
    const int tid = c.tid, fr = c.fr, fq = c.fq, w = c.wave;
    bf16* ksl = (bf16*)c.lds; bf16* snl = (bf16*)(c.lds + 34816); bf16* vl = (bf16*)(c.lds + 69632); float* Gs = (float*)(c.lds + 104448);
    bf16* dv = (bf16*)(c.ws + WS_DV);
#pragma unroll
    for (int s = 0; s < 4; ++s) { const int idx = tid + 512 * s, r = idx >> 4, c8 = (idx & 15) * 8;
        const int o = 8 * idx, cT = (((o >> 11) & 7) << 4) | ((o >> 4) & 15), iT = (((o >> 8) & 7) << 4) | (o & 15);
        *(u32x4*)(ksl + r * 136 + c8) = p.kk[s]; *(u32x4*)(vl + cT * 136 + iT) = p.vv[s]; *(u32x4*)(snl + cT * 136 + iT) = p.ss[s]; }
    if (tid < 128) Gs[tid] = p.g;
    bf16* qsl = (bf16*)(c.lds + 104960);
    { const int col8 = 8 * (tid & 15), i4 = 4 * (tid >> 4);
      f32x4 w0[4], w1[4];
#pragma unroll
      for (int k = 0; k < 4; ++k) { const float* wp = c.dn_conv_w + (size_t)k * 3072 + h * 128 + col8; w0[k] = *(const f32x4*)wp; w1[k] = *(const f32x4*)(wp + 4); }
#pragma unroll
      for (int r = 0; r < 4; ++r) { f32x4 a0 = (f32x4){0.f, 0.f, 0.f, 0.f}, a1 = a0;
#pragma unroll
          for (int k = 0; k < 4; ++k) { f32x4 x0, x1; unpack8(p.qraw[r + k], x0, x1); a0 = a0 + x0 * w0[k]; a1 = a1 + x1 * w1[k]; }
          float sq = 0.f;
#pragma unroll
          for (int e = 0; e < 4; ++e) { a0[e] = silu_f(a0[e]); a1[e] = silu_f(a1[e]); sq += a0[e] * a0[e] + a1[e] * a1[e]; }
          sq += __shfl_xor(sq, 1); sq += __shfl_xor(sq, 2); sq += __shfl_xor(sq, 4); sq += __shfl_xor(sq, 8);
          const float rn = rsqrtf(sq + EPS);
          *(u32x4*)(qsl + (i4 + r) * 136 + col8) = pack8(a0 * rn, a1 * rn); } }
    __syncthreads();
    dn_out_load(c, next_id, p);
    const int i0 = 16 * w, i = i0 + fr; const float scale = 0.08838834764831845f;
    bf16x8 qA[4];
#pragma unroll
    for (int kk = 0; kk < 4; ++kk) qA[kk] = *(const bf16x8*)(qsl + i * 136 + 32 * kk + 8 * fq);
    const float Gi = Gs[i], rowsc = __expf(Gi) * scale;
    f32x4 O[8];
#pragma unroll
    for (int ct = 0; ct < 8; ++ct) { f32x4 acc = (f32x4){0.f, 0.f, 0.f, 0.f};
#pragma unroll
        for (int kk = 0; kk < 4; ++kk) acc = mfma32(*(const bf16x8*)(snl + (16 * ct + fr) * 136 + 32 * kk + 8 * fq), qA[kk], acc);
        O[ct] = acc * rowsc; }
    for (int jt = 0; jt <= w; ++jt) {
        f32x4 p = (f32x4){0.f, 0.f, 0.f, 0.f};
#pragma unroll
        for (int kk = 0; kk < 4; ++kk) p = mfma32(*(const bf16x8*)(ksl + (16 * jt + fr) * 136 + 32 * kk + 8 * fq), qA[kk], p);
        const f32x4 G4 = *(const f32x4*)(Gs + 16 * jt + 4 * fq);
#pragma unroll
        for (int r = 0; r < 4; ++r) { const int j = 16 * jt + 4 * fq + r; p[r] = (i >= j) ? p[r] * scale * __expf(Gi - G4[r]) : 0.f; }
        const bf16x4 pb = pack4(p);
#pragma unroll
        for (int ct = 0; ct < 8; ++ct) O[ct] = mfma16(*(const bf16x4*)(vl + (16 * ct + fr) * 136 + 16 * jt + 4 * fq), pb, O[ct]);
    }
    float ssq = 0.f;
#pragma unroll
    for (int ct = 0; ct < 8; ++ct) ssq += (O[ct][0] * O[ct][0] + O[ct][1] * O[ct][1]) + (O[ct][2] * O[ct][2] + O[ct][3] * O[ct][3]);
    ssq += __shfl_xor(ssq, 16); ssq += __shfl_xor(ssq, 32);
    const float rstd = rsqrtf(ssq * (1.f / 128.f) + EPS);
#pragma unroll
    for (int ct = 0; ct < 8; ++ct) { const int cc = 16 * ct + 4 * fq; const f32x4 g4 = *(const f32x4*)(c.dn_norm_g + cc);
        *(bf16x4*)(dv + (size_t)(rowbase + i) * 1024 + h * 128 + cc) = pack4(O[ct] * rstd * g4); }
    __syncthreads();
}
__device__ __forceinline__ void ret_out(const Ctx& c, int id) {
    const int bh = id >> 5, n = id & 31, b = bh >> 3, h = bh & 7, rowbase = b * T + n * CH;
    const int tid = c.tid, fr = c.fr, fq = c.fq, w = c.wave;
    bf16* ksl = (bf16*)c.lds; bf16* snl = (bf16*)(c.lds + 18432); bf16* vl = (bf16*)(c.lds + 36864);
    const bf16* rq = (const bf16*)(c.ws + WS_RQ); const bf16* rk = (const bf16*)(c.ws + WS_RK); bf16* rv = (bf16*)(c.ws + WS_RV); const bf16* sp = (const bf16*)(c.ws + WS_KV) + (size_t)id * 8192;
#pragma unroll
    for (int s = 0; s < 2; ++s) { const int idx = tid + 512 * s, r = idx >> 3, c8 = (idx & 7) * 8;
        *(u32x4*)(ksl + r * 72 + c8) = *(const u32x4*)(rk + (size_t)(rowbase + r) * 512 + h * 64 + c8);
        *(u32x4*)(snl + r * 72 + c8) = *(const u32x4*)(sp + r * 64 + c8); }
    { const int c8 = 8 * (tid & 15), j4 = 4 * (tid >> 4); u32x4 p[4];
#pragma unroll
      for (int r = 0; r < 4; ++r) p[r] = *(const u32x4*)(rv + (size_t)(rowbase + j4 + r) * 1024 + h * 128 + c8);
      strip_transpose_store(vl, 136, c8, j4, p); }
    __syncthreads();
    const int i0 = 16 * w, i = i0 + fr; const float lg = ret_logg(h);
    bf16x8 qA[2];
#pragma unroll
    for (int kk = 0; kk < 2; ++kk) qA[kk] = *(const bf16x8*)(rq + (size_t)(rowbase + i) * 512 + h * 64 + 32 * kk + 8 * fq);
    const float xi = __expf(lg * (float)(i + 1));
    f32x4 O[8];
#pragma unroll
    for (int ct = 0; ct < 8; ++ct) { f32x4 acc = (f32x4){0.f, 0.f, 0.f, 0.f};
#pragma unroll
        for (int kk = 0; kk < 2; ++kk) acc = mfma32(*(const bf16x8*)(snl + (16 * ct + fr) * 72 + 32 * kk + 8 * fq), qA[kk], acc);
        O[ct] = acc * xi; }
    for (int jt = 0; jt <= w; ++jt) {
        f32x4 p = (f32x4){0.f, 0.f, 0.f, 0.f};
#pragma unroll
        for (int kk = 0; kk < 2; ++kk) p = mfma32(*(const bf16x8*)(ksl + (16 * jt + fr) * 72 + 32 * kk + 8 * fq), qA[kk], p);
#pragma unroll
        for (int r = 0; r < 4; ++r) { const int j = 16 * jt + 4 * fq + r; p[r] = (i >= j) ? p[r] * __expf(lg * (float)(i - j)) : 0.f; }
        const bf16x4 pb = pack4(p);
#pragma unroll
        for (int ct = 0; ct < 8; ++ct) O[ct] = mfma16(*(const bf16x4*)(vl + (16 * ct + fr) * 136 + 16 * jt + 4 * fq), pb, O[ct]);
    }
    float sm = 0.f;
#pragma unroll
    for (int ct = 0; ct < 8; ++ct) sm += (O[ct][0] + O[ct][1]) + (O[ct][2] + O[ct][3]);
    sm += __shfl_xor(sm, 16); sm += __shfl_xor(sm, 32);
    const float mu = sm * (1.f / 128.f); float vs = 0.f;
#pragma unroll
    for (int ct = 0; ct < 8; ++ct) { O[ct] = O[ct] - mu; vs += (O[ct][0] * O[ct][0] + O[ct][1] * O[ct][1]) + (O[ct][2] * O[ct][2] + O[ct][3] * O[ct][3]); }
    vs += __shfl_xor(vs, 16); vs += __shfl_xor(vs, 32);
    const float rstd = rsqrtf(vs * (1.f / 128.f) + GN_EPS);
#pragma unroll
    for (int ct = 0; ct < 8; ++ct) { const int cc = 16 * ct + 4 * fq; const f32x4 g4 = *(const f32x4*)(c.ret_norm_g + h * 128 + cc);
        *(bf16x4*)(rv + (size_t)(rowbase + i) * 1024 + h * 128 + cc) = pack4(O[ct] * rstd * g4); }
    __syncthreads();
}

__device__ __forceinline__ void ffn_fixup(const Ctx& c, int pm) {
    bf16* act = (bf16*)(c.ws + WS_ACT); const bf16* hbuf = (const bf16*)(c.ws + WS_HBUF);
    constexpr int NJ4 = DFF / 4;
    for (int idx = c.tid; idx < 8 * NJ4; idx += 512) {
        const int j0 = (idx % NJ4) * 4, gr = idx / NJ4, g = 4 * pm + (gr >> 1), r = gr & 1, col = 2 * j0;
        const bool first = ((g * 64) & (T - 1)) == 0;
        u32x4 u0, u1 = (u32x4){0u, 0u, 0u, 0u}, u2 = u1;
        u0 = *(const u32x4*)(hbuf + ((size_t)g * 4 + r) * NUP + col);
        if (r == 1) { u1 = *(const u32x4*)(hbuf + ((size_t)g * 4 + 0) * NUP + col); if (!first) u2 = *(const u32x4*)(hbuf + ((size_t)(g - 1) * 4 + 3) * NUP + col); }
        else if (!first) { u1 = *(const u32x4*)(hbuf + ((size_t)(g - 1) * 4 + 3) * NUP + col); u2 = *(const u32x4*)(hbuf + ((size_t)(g - 1) * 4 + 2) * NUP + col); }
        f32x4 c0, c1, p10, p11, p20, p21; unpack8(u0, c0, c1); unpack8(u1, p10, p11); unpack8(u2, p20, p21);
        f32x4 wa[3], wb[3];
#pragma unroll
        for (int k = 0; k < 3; ++k) { wa[k] = *(const f32x4*)(c.ffn_conv_w + (size_t)k * NUP + j0); wb[k] = *(const f32x4*)(c.ffn_conv_w + (size_t)k * NUP + DFF + j0); }
        const f32x4 ba = *(const f32x4*)(c.ffn_conv_b + j0), bb = *(const f32x4*)(c.ffn_conv_b + DFF + j0);
        const f32x4 xa = (f32x4){c0[0], c0[2], c1[0], c1[2]}, xb = (f32x4){c0[1], c0[3], c1[1], c1[3]};
        const f32x4 xa1 = (f32x4){p10[0], p10[2], p11[0], p11[2]}, xb1 = (f32x4){p10[1], p10[3], p11[1], p11[3]};
        const f32x4 xa2 = (f32x4){p20[0], p20[2], p21[0], p21[2]}, xb2 = (f32x4){p20[1], p20[3], p21[1], p21[3]};
        const f32x4 ya = wa[0] * xa2 + wa[1] * xa1 + wa[2] * xa + ba, yb = wb[0] * xb2 + wb[1] * xb1 + wb[2] * xb + bb;
        f32x4 o;
#pragma unroll
        for (int e = 0; e < 4; ++e) o[e] = silu_f(ya[e]) * yb[e];
        *(bf16x4*)(act + (size_t)(g * 64 + r) * DFF + j0) = pack4(o);
    }
}

#define XB_TMO      128
#define XB_XCNT(j)  (256  + 64 * (j))
#define XB_XSUB(j)  (1280 + 64 * (j))
#define XB_XGEN(j)  (2304 + 64 * (j))
#define XB_TOP      3328
#define XB_TOPGEN   3392
#define XCD_BAR_WORDS 3456
#define XB_SPIN_CAP (1u << 18)

__device__ __forceinline__ unsigned xb_ld(unsigned* p)              { return __hip_atomic_load(p, __ATOMIC_RELAXED, __HIP_MEMORY_SCOPE_AGENT); }
__device__ __forceinline__ unsigned xb_add(unsigned* p, unsigned v) { return __hip_atomic_fetch_add(p, v, __ATOMIC_RELAXED, __HIP_MEMORY_SCOPE_AGENT); }
__device__ __forceinline__ unsigned xb_xcc_id() { return (unsigned)__builtin_amdgcn_s_getreg((3 << 11) | 20) & 0xFu; }
#define XB_SPIN(cond, bar) do { unsigned _sp = 0; while (cond) { __builtin_amdgcn_s_sleep(1); \
    if ((++_sp & 255u) == 0u) { if (xb_ld(&(bar)[XB_TMO])) break; if (_sp > XB_SPIN_CAP) { atomicAdd(&(bar)[XB_TMO], 1u); break; } } } } while (0)

struct XcdBarrier {
    unsigned* bar; unsigned x;
    volatile PG8_LAS unsigned* st;
};

__device__ __forceinline__ XcdBarrier xcd_barrier_post(unsigned* bar, volatile PG8_LAS unsigned* st) {
    XcdBarrier b; b.bar = bar; b.x = xb_xcc_id(); b.st = st;
    if (threadIdx.x == 0) (void)xb_add(&bar[XB_XCNT(b.x)], 1u);
    return b;
}
__device__ __forceinline__ void xcd_barrier_complete(unsigned* bar, unsigned x, unsigned& nloc, unsigned& nx) {
    const unsigned G = gridDim.x * gridDim.y * gridDim.z;
    unsigned sum, cnt, mine, sp = 0u;
    for (;;) {
        sum = 0u; cnt = 0u; mine = 0u;
#pragma unroll
        for (unsigned j = 0; j < 16; ++j) { const unsigned c = xb_ld(&bar[XB_XCNT(j)]); sum += c; cnt += (c > 0u) ? 1u : 0u; mine = (j == x) ? c : mine; }
        if (sum == G) break;
        __builtin_amdgcn_s_sleep(1);
        if ((++sp & 255u) == 0u) { if (xb_ld(&bar[XB_TMO])) break; if (sp > XB_SPIN_CAP) { atomicAdd(&bar[XB_TMO], 1u); break; } }
    }
    nloc = mine > 0u ? mine : 1u; nx = cnt > 0u ? cnt : 1u;
}

__device__ __forceinline__ void xcd_barrier(const XcdBarrier& b) {
    asm volatile("s_waitcnt vmcnt(0)" ::: "memory");
    __syncthreads();
    if (threadIdx.x == 0) {
        unsigned* bar = b.bar;
        __builtin_amdgcn_s_waitcnt(0);
        unsigned nloc = b.st[0], nx = b.st[1];
        if (nloc == 0u) { xcd_barrier_complete(bar, b.x, nloc, nx); b.st[0] = nloc; b.st[1] = nx; }
        const unsigned old = xb_add(&bar[XB_XSUB(b.x)], 1u);
        const unsigned gen = old / nloc;
        if (old + 1u == (gen + 1u) * nloc) {
            __builtin_amdgcn_fence(__ATOMIC_RELEASE, "agent");
            asm volatile("s_waitcnt vmcnt(0)" ::: "memory");
            const unsigned og = xb_add(&bar[XB_TOP], 1u);
            const unsigned tg = og / nx;
            if (og + 1u == (tg + 1u) * nx) xb_add(&bar[XB_TOPGEN], 1u);
            else XB_SPIN(xb_ld(&bar[XB_TOPGEN]) == tg, bar);
            __builtin_amdgcn_fence(__ATOMIC_ACQUIRE, "agent");
            xb_add(&bar[XB_XGEN(b.x)], 1u);
            asm volatile("s_waitcnt vmcnt(0)" ::: "memory");
        } else {
            XB_SPIN(xb_ld(&bar[XB_XGEN(b.x)]) == gen, bar);
            __builtin_amdgcn_fence(__ATOMIC_ACQUIRE, "agent");
            asm volatile("s_waitcnt vmcnt(0)" ::: "memory");
        }
    }
    __syncthreads();
}

struct PairOrder {
    pg8::StaticOrder base;
    __device__ bool next(int i, pg8::Unit& u) const { if (!base.next(i >> 1, u)) return false; if (i & 1) { u.pm += 192; u.pn += 4; } return true; }
    __device__ __forceinline__ void a_ready(const pg8::Unit&) const {}
    __device__ __forceinline__ void done(const pg8::Unit&) const {}
};
struct Epi6 {
    static constexpr bool PERM = true, AFTER_DRAIN = false; bf16* sigr; const bf16* sigd;
    __device__ __forceinline__ void operator()(const pg8::f32x4 (&acc)[2][2][4][2], const pg8::Unit& u, int wr, int wc, int fr, int fq) const {
        const bool second = u.pn >= 4; const int pm = second ? u.pm - 192 : u.pm, pn = second ? u.pn - 4 : u.pn;
#pragma unroll
        for (int ai = 0; ai < 2; ++ai)
#pragma unroll
            for (int m = 0; m < 4; ++m) { const int row = pm * 256 + ai * 128 + wr * 64 + m * 16 + fr;
#pragma unroll
                for (int bj = 0; bj < 2; ++bj) { const int col = pn * 256 + bj * 128 + wc * 32 + 8 * fq; bf16* p = sigr + (size_t)row * 1024 + col;
                    f32x4 a, b; unpack8(*(const u32x4*)p, a, b);
                    if (!second) { a = a * acc[ai][bj][m][0]; b = b * acc[ai][bj][m][1]; }
                    else { f32x4 s0, s1; unpack8(*(const u32x4*)(sigd + (size_t)row * 1024 + col), s0, s1); a = a + s0 * acc[ai][bj][m][0]; b = b + s1 * acc[ai][bj][m][1]; }
                    *(u32x4*)p = pack8(a, b); } }
    }
};
template <int K> __device__ __forceinline__ void run_phase(const Ctx& c, unsigned char* lds, PG8_LAS unsigned char* ldsl, unsigned char* ws, bf16* outb) {

    if constexpr (K == 0) phase0(c);
    if constexpr (K == 1) {
        pg8::Gemm g{(const bf16*)(ws + WS_UX), (const bf16*)(ws + WS_WIN) + (size_t)N5 * 1024, M, N1, 1024, 1024, 1024}; pg8::StaticOrder S; S.init(M, N1, c.G, c.bid);
        EpiRow8<F1> E{F1{(const float*)(ws + WS_R1), (const float*)(ws + WS_ROPE), (bf16*)(ws + WS_RQ), (bf16*)(ws + WS_RK), (bf16*)(ws + WS_RV), (bf16*)(ws + WS_DQ), (bf16*)(ws + WS_HALO)}};
        pg8::gemm_phase<EpiRow8<F1>, pg8::StaticOrder, true, true>(ldsl, g, S, E);
    }
    if constexpr (K == 2) {
        for (int id = c.bid; id < 1024; id += c.G) dn_prep(c, id);
        for (int id = c.bid; id < 1024; id += c.G) ret_kv(c, id);
    }
    if constexpr (K == 3) phase3(c);
    if constexpr (K == 4) {
#ifndef DBG_SKIP_OUT
        { DnPre pre; if (c.bid < 1024) dn_out_load(c, c.bid, pre);
          for (int id = c.bid; id < 1024; id += c.G) dn_out(c, id, (id + c.G < 1024) ? id + c.G : id, pre); }
        for (int id = c.bid; id < 1024; id += c.G) ret_out(c, id);
#endif
    }
    if constexpr (K == 5) {
        {
          float* scr = (float*)(lds + c.wave * 16384); const int gw = c.bid * 8 + c.wave, ngw = c.G * 8;
          constexpr int I_SQ = 16 * 32, I_UP = 16 * (NUP / 32), I_DN = (DFF / 64) * 32;
          for (int it = gw; it < 3 * I_SQ + I_UP + I_DN; it += ngw) {
              if (it < I_SQ) transpose_item<0>(c.w_ret_br, 1024, 1024, (bf16*)(ws + WS_WRET), nullptr, scr, it, 32, c.lane);
              else if (it < 2 * I_SQ) transpose_item<0>(c.w_dn_br, 1024, 1024, (bf16*)(ws + WS_WDN), nullptr, scr, it - I_SQ, 32, c.lane);
              else if (it < 3 * I_SQ) transpose_item<0>(c.w_o, 1024, 1024, (bf16*)(ws + WS_WO), nullptr, scr, it - 2 * I_SQ, 32, c.lane);
              else if (it < 3 * I_SQ + I_UP) transpose_item<2>(c.w_up, 1024, NUP, (bf16*)(ws + WS_WUP), c.g_ffn, scr, it - 3 * I_SQ, NUP / 32, c.lane);
              else transpose_item<0>(c.w_down, DFF, 1024, (bf16*)(ws + WS_WDOWN), nullptr, scr, it - 3 * I_SQ - I_UP, 32, c.lane); }
          __syncthreads(); }
        pg8::Gemm g{(const bf16*)(ws + WS_UX), (const bf16*)(ws + WS_WIN), M, N5, 1024, 1024, 1024}; pg8::StaticOrder S; S.init(M, N5, c.G, c.bid);
        EpiRow8<F5> E{F5{(const float*)(ws + WS_R1), (bf16*)(ws + WS_RV), (bf16*)(ws + WS_DV), (bf16*)(ws + WS_DQ), (bf16*)(ws + WS_DK)}};
        pg8::gemm_phase<EpiRow8<F5>, pg8::StaticOrder, true, true>(ldsl, g, S, E);
    }
    if constexpr (K == 6) {
        static_assert(WS_DV - WS_RV == (size_t)192 * 256 * 1024 * 2 && WS_WDN - WS_WRET == (size_t)4 * 256 * 1024 * 2, "tile offsets of the second GEMM");
        PairOrder S; S.base.init(M, 1024, c.G, c.bid);
        pg8::Gemm g{(const bf16*)(ws + WS_RV), (const bf16*)(ws + WS_WRET), M, 1024, 1024, 1024, 1024};
        Epi6 E{(bf16*)(ws + WS_DQ), (const bf16*)(ws + WS_DK)};
        pg8::gemm_phase<Epi6, PairOrder, true, true>(ldsl, g, S, E);
    }
    if constexpr (K == 7) {
        pg8::Gemm g{(const bf16*)(ws + WS_DQ), (const bf16*)(ws + WS_WO), M, 1024, 1024, 1024, 1024}; pg8::StaticOrder S; S.init(M, 1024, c.G, c.bid);
        EpiRes<true> E{c.x, (bf16*)(ws + WS_H1B), (float*)(ws + WS_SS1)};
        pg8::gemm_phase<EpiRes<true>, pg8::StaticOrder, true, true>(ldsl, g, S, E);
    }
    if constexpr (K == 8) {
        pg8::Gemm g{(const bf16*)(ws + WS_H1B), (const bf16*)(ws + WS_WUP), M, NUP, 1024, 1024, 1024}; pg8::StaticOrder S; S.init(M, NUP, c.G, c.bid);
        Epi8 E{(const float*)(ws + WS_SS1), (bf16*)(ws + WS_ACT), (bf16*)(ws + WS_HBUF), c.ffn_conv_w, c.ffn_conv_b};
        pg8::gemm_phase<Epi8, pg8::StaticOrder, true, true>(ldsl, g, S, E);
#ifdef TIMING_DUP_P8
        __syncthreads();
        pg8::gemm_phase<Epi8, pg8::StaticOrder, true, true>(ldsl, g, S, E);
#endif
    }
    if constexpr (K == 10) {
        pg8::Gemm g{(const bf16*)(ws + WS_ACT), (const bf16*)(ws + WS_WDOWN), M, 1024, DFF, DFF, DFF}; pg8::StaticOrder S; S.init(M, 1024, c.G, c.bid);
        { pg8::Unit u; int last_pm = -1; for (int i = 0; S.next(i, u); ++i) if (u.pm != last_pm) { ffn_fixup(c, u.pm); last_pm = u.pm; }
          asm volatile("s_waitcnt vmcnt(0)" ::: "memory"); __syncthreads(); }
        EpiRes<false> E{nullptr, (bf16*)(ws + WS_H1B), (float*)(ws + WS_SS2)};
        pg8::gemm_phase<EpiRes<false>, pg8::StaticOrder, true, true>(ldsl, g, S, E);
    }
    if constexpr (K == 11) {
        const float* ss2 = (const float*)(ws + WS_SS2);
        const int gw = c.bid * 8 + c.wave, ngw = c.G * 8;
        for (int rb = gw; rb < M; rb += 4 * ngw) {
            u32x4 hv[4][2]; float pv[4];
#pragma unroll
            for (int j = 0; j < 4; ++j) { const int row = rb + j * ngw; const bool ok = row < M; const int rr = ok ? row : rb;
                const u32x4* hp = (const u32x4*)((const bf16*)(ws + WS_H1B) + (size_t)rr * 1024) + c.lane;
                hv[j][0] = hp[0]; hv[j][1] = hp[64]; pv[j] = (c.lane < 16) ? ss2[(size_t)rr * 16 + c.lane] : 0.f; }
#pragma unroll
            for (int j = 0; j < 4; ++j) { const int row = rb + j * ngw; if (row >= M) continue;
                float sm = pv[j];
#pragma unroll
                for (int o = 1; o < 16; o <<= 1) sm += __shfl_xor(sm, o);
                sm = __shfl(sm, 0);
                const float r = rsqrtf(sm * (1.f / 1024.f) + EPS);
                f32x4* p = (f32x4*)(c.out + (size_t)row * 1024) + 2 * c.lane;
#pragma unroll
                for (int q = 0; q < 2; ++q) { f32x4 a0, a1; unpack8(hv[j][q], a0, a1);
                    const f32x4 g0 = *((const f32x4*)c.g_final + 128 * q + 2 * c.lane), g1 = *((const f32x4*)c.g_final + 128 * q + 2 * c.lane + 1);
                    p[128 * q] = a0 * r * g0; p[128 * q + 1] = a1 * r * g1; } }
        }
    }
}
struct Args { const float* in[17]; float* out; unsigned char* ws; int ph_lo, ph_hi; };
__global__ void __launch_bounds__(512) fwd_kernel(Args args) {
    extern __shared__ __attribute__((aligned(16))) unsigned char lds[];
    cg::grid_group grid = cg::this_grid();
    Ctx c;
    c.x = args.in[0]; c.g_mix = args.in[1]; c.w_in = args.in[2]; c.ret_norm_g = args.in[3]; c.dn_conv_w = args.in[4]; c.dn_a_log = args.in[5]; c.dn_dt_bias = args.in[6]; c.dn_norm_g = args.in[7];
    c.w_ret_br = args.in[8]; c.w_dn_br = args.in[9]; c.w_o = args.in[10]; c.g_ffn = args.in[11]; c.w_up = args.in[12]; c.ffn_conv_w = args.in[13]; c.ffn_conv_b = args.in[14]; c.w_down = args.in[15]; c.g_final = args.in[16];
    c.out = args.out; c.ws = args.ws; c.lds = lds;
    c.tid = threadIdx.x; c.lane = c.tid & 63; c.wave = __builtin_amdgcn_readfirstlane(c.tid >> 6); c.bid = blockIdx.x; c.G = gridDim.x; c.fr = c.lane & 15; c.fq = c.lane >> 4;
    PG8_LAS unsigned char* ldsl = (PG8_LAS unsigned char*)lds;
    const int lo = args.ph_lo, hi = args.ph_hi;
    unsigned char* ws = args.ws;
    bf16* outb = (bf16*)args.out;
#ifndef PROGRAM_STEPS
#define PROGRAM_STEPS STEP(0, 0) STEP(1, 1) STEP(2, 2) STEP(3, 3) STEP(4, 4) STEP(5, 5) STEP(6, 6) STEP(7, 7) STEP(8, 8) STEP(9, 10) STEP(10, 11)
#endif
    volatile PG8_LAS unsigned* bst = (volatile PG8_LAS unsigned*)(ldsl + LDS_BYTES - 64);
    if (c.tid < 16) bst[c.tid] = 0u;
    __syncthreads();
    XcdBarrier bar = xcd_barrier_post((unsigned*)(ws + WS_CTL), bst);
    if (lo == 0 && hi > 1) grid.sync();
#define STEP(i, k) if (lo <= (i) && (i) < hi) run_phase<k>(c, lds, ldsl, ws, outb); if (lo <= (i) && (i) + 1 < hi) xcd_barrier(bar);
    PROGRAM_STEPS
#undef STEP
#ifdef DBG_DUMP_OFF
    if (lo == 12) {
        const bf16* src = (const bf16*)(ws + (size_t)DBG_DUMP_OFF);
        for (size_t idx = (size_t)c.bid * 512 + c.tid; idx < (size_t)M * 1024; idx += (size_t)c.G * 512) { float v = bf2f(src[idx]); c.out[idx] = (v == v && fabsf(v) < 1e30f) ? v : 12345.f; }
    }
#endif
}

extern "C" void kernel_launch(void* const* d_in, const int* in_sizes, int n_in, void* d_out, int out_size, void* d_ws, size_t ws_size, hipStream_t stream) {
    static int grid = 0;
    if (grid == 0) {
        if (n_in != 17 || out_size != M * D || ws_size < WS_END) { fprintf(stderr, "kernel_launch: unexpected shapes (n_in %d out %d ws %zu)\n", n_in, out_size, ws_size); grid = -1; return; }
        int dev = 0, cus = 0, per_cu = 0;
        if (hipGetDevice(&dev) != hipSuccess || hipDeviceGetAttribute(&cus, hipDeviceAttributeMultiprocessorCount, dev) != hipSuccess) { grid = -1; return; }
        if (hipFuncSetAttribute((const void*)fwd_kernel, hipFuncAttributeMaxDynamicSharedMemorySize, LDS_BYTES) != hipSuccess) { fprintf(stderr, "kernel_launch: hipFuncSetAttribute failed\n"); grid = -1; return; }
        if (hipOccupancyMaxActiveBlocksPerMultiprocessor(&per_cu, (const void*)fwd_kernel, 512, LDS_BYTES) != hipSuccess || per_cu < 1) { fprintf(stderr, "kernel_launch: occupancy query says %d\n", per_cu); per_cu = 1; }
        (void)hipGetLastError();
        grid = cus;
    }
    if (grid < 0) return;
    Args a{};
    for (int i = 0; i < 17; ++i) a.in[i] = (const float*)d_in[i];
    a.out = (float*)d_out; a.ws = (unsigned char*)d_ws;
#if N_LAUNCH_MODE == 1
    if (hipMemsetAsync((char*)d_ws + WS_CTL, 0, CTL_BYTES, stream) != hipSuccess) { fprintf(stderr, "kernel_launch: memset of the barrier words failed\n"); return; }
    a.ph_lo = 0; a.ph_hi = NPHASE;
    void* kargs[] = {&a};
    hipError_t e = hipLaunchCooperativeKernel((const void*)fwd_kernel, dim3(grid), dim3(512), kargs, LDS_BYTES, stream);
    if (e != hipSuccess) fprintf(stderr, "kernel_launch: cooperative launch failed: %s (grid %d)\n", hipGetErrorString(e), grid);
#else
    for (int ph = 0; ph < NPHASE; ++ph) { a.ph_lo = ph; a.ph_hi = ph + 1; hipLaunchKernelGGL(fwd_kernel, dim3(grid), dim3(512), LDS_BYTES, stream, a); }
#ifdef DBG_DUMP_OFF
    a.ph_lo = 12; a.ph_hi = 13; hipLaunchKernelGGL(fwd_kernel, dim3(grid), dim3(512), LDS_BYTES, stream, a);
#endif
#endif
}
```
